# Optimizing an MI355X kernel written in HIP

```python
import math
import jax, jax.numpy as jnp
from jax import lax
import numpy as np

D_MODEL = 1024
BATCH = 8
SEQ = 8192
DEPTH = 1

HEAD_DIM = 64
POOL_WINDOWS = (2, 4, 8, 16)
POOL_GROUP_DIM = D_MODEL // 16
POOL_DIM = len(POOL_WINDOWS) * POOL_GROUP_DIM
ATTN_GROUPS = ((128, 1), (512, 4), (2048, 16))
N_ATTN_HEADS = (D_MODEL - POOL_DIM) // HEAD_DIM
HEADS_PER_GROUP = N_ATTN_HEADS // len(ATTN_GROUPS)
ATTN_DIM = N_ATTN_HEADS * HEAD_DIM
D_MIX = POOL_DIM + ATTN_DIM
D_IN = POOL_DIM + 3 * ATTN_DIM
D_FF = 64 * int(math.ceil(8 * D_MODEL / (3 * 64)))
RMS_EPS = 1e-6

kernel_name = "hymba_pool_dilated_alibi_macaron"


def alibi_slopes():
    s = np.array([2.0 ** (-8.0 * (i + 1) / N_ATTN_HEADS) for i in range(N_ATTN_HEADS)], np.float32)
    return jnp.asarray(s)


def rmsnorm(x, g):
    xf = x.astype(jnp.float32)
    y = xf * lax.rsqrt(jnp.mean(xf * xf, axis=-1, keepdims=True) + RMS_EPS)
    return (y * g.astype(jnp.float32)).astype(x.dtype)


def swiglu(h, w_gate, w_up, w_down):
    return (jax.nn.silu(h @ w_gate) * (h @ w_up)) @ w_down


def pool_mixer(u, w_lin, scale):
    B, S, _ = u.shape
    G = len(POOL_WINDOWS)
    uf = u.astype(jnp.float32).reshape(B, S, G, POOL_GROUP_DIM)
    csum = jnp.concatenate([jnp.zeros((B, 1, G, POOL_GROUP_DIM), jnp.float32),
                            jnp.cumsum(uf, axis=1)], axis=1)
    t = jnp.arange(S)
    outs = []
    for g, w in enumerate(POOL_WINDOWS):
        lo = jnp.clip(t - w // 2, 0, S)
        hi = jnp.clip(t - w // 2 + w, 0, S)
        cg = csum[:, :, g]
        win_sum = jnp.take(cg, hi, axis=1) - jnp.take(cg, lo, axis=1)
        mean = win_sum / (hi - lo).astype(jnp.float32)[None, :, None]
        outs.append(mean - uf[:, :, g])
    y = jnp.stack(outs, axis=2).astype(u.dtype)
    y = jnp.einsum('bsgc,gce->bsge', y, w_lin)
    return y.reshape(B, S, POOL_DIM) * scale


def dilated_window_attention(q, k, v, window, dilation, slopes):
    B, S, H, Dh = q.shape
    n_side = (window // 2) // dilation
    blk = n_side
    L = S // dilation
    nb = -(-L // blk)
    Lp = nb * blk

    def to_sub(a):
        return a.reshape(B, L, dilation, H, Dh).transpose(0, 2, 1, 3, 4).reshape(B * dilation, L, H, Dh)

    def windows(a):
        a = jnp.pad(to_sub(a), ((0, 0), (blk, Lp - L + blk), (0, 0), (0, 0)))
        a = a.reshape(-1, nb + 2, blk, H, Dh)
        return jnp.concatenate([a[:, :-2], a[:, 1:-1], a[:, 2:]], axis=2)

    qs = jnp.pad(to_sub(q), ((0, 0), (0, Lp - L), (0, 0), (0, 0))).reshape(-1, nb, blk, H, Dh)
    kw, vw = windows(k), windows(v)

    rel = jnp.arange(3 * blk)[None, :] - blk - jnp.arange(blk)[:, None]
    key_idx = (jnp.arange(nb)[:, None] - 1) * blk + jnp.arange(3 * blk)[None, :]
    valid = (jnp.abs(rel) <= n_side)[None] & ((key_idx >= 0) & (key_idx < L))[:, None, :]
    dist = (jnp.abs(rel) * dilation).astype(jnp.float32)
    bias = -slopes.astype(jnp.float32)[:, None, None] * dist[None]

    s = jnp.einsum('znqhd,znkhd->znhqk', qs, kw).astype(jnp.float32) * (Dh ** -0.5)
    s = jnp.where(valid[None, :, None], s + bias[None, None], -jnp.inf)
    m = jnp.max(s, axis=-1, keepdims=True)
    p = jnp.exp(s - m)
    den = jnp.sum(p, axis=-1)
    o = jnp.einsum('znhqk,znkhd->znqhd', p, vw.astype(jnp.float32))
    den_t = jnp.swapaxes(den, 2, 3)
    o = o / den_t[..., None]
    lse = jnp.swapaxes(m[..., 0], 2, 3) + jnp.log(den_t)

    def from_sub(a):
        a = a.reshape((B, dilation, Lp) + a.shape[3:])[:, :, :L]
        a = jnp.swapaxes(a, 1, 2)
        return a.reshape((B, S) + a.shape[3:])

    return from_sub(o), from_sub(lse)


def attention_mixer(q, k, v):
    B, S = q.shape[:2]
    slopes = alibi_slopes()
    outs, lses = [], []
    for gi, (window, dilation) in enumerate(ATTN_GROUPS):
        hs = slice(gi * HEADS_PER_GROUP, (gi + 1) * HEADS_PER_GROUP)
        o, lse = dilated_window_attention(q[:, :, hs], k[:, :, hs], v[:, :, hs],
                                          window, dilation, slopes[hs])
        outs.append(o)
        lses.append(lse)
    alpha = jax.nn.softmax(jnp.stack(lses, axis=0), axis=0)
    o = jnp.concatenate([outs[g] * alpha[g][..., None] for g in range(len(ATTN_GROUPS))], axis=2)
    return o.reshape(B, S, ATTN_DIM).astype(q.dtype)


def setup_inputs(seed: int = 0) -> dict:
    key = jax.random.key(seed)
    ks = jax.random.split(key, 20)
    f32 = jnp.float32

    def nrm(k, shape, fan_in):
        return jax.random.normal(k, shape, f32) * (fan_in ** -0.5)

    def gain(k, n):
        return 1.0 + 0.02 * jax.random.normal(k, (DEPTH, n), f32)

    return {
        "x": jax.random.normal(ks[0], (BATCH, SEQ, D_MODEL), f32),
        "g_ffn1_pre": gain(ks[1], D_MODEL),
        "w1_gate": nrm(ks[2], (DEPTH, D_MODEL, D_FF), D_MODEL),
        "w1_up": nrm(ks[3], (DEPTH, D_MODEL, D_FF), D_MODEL),
        "w1_down": nrm(ks[4], (DEPTH, D_FF, D_MODEL), D_FF),
        "g_ffn1_post": gain(ks[5], D_MODEL),
        "g_mix_pre": gain(ks[6], D_MODEL),
        "w_in": nrm(ks[7], (DEPTH, D_MODEL, D_IN), D_MODEL),
        "w_pool_lin": nrm(ks[8], (DEPTH, len(POOL_WINDOWS), POOL_GROUP_DIM, POOL_GROUP_DIM), POOL_GROUP_DIM),
        "pool_scale": gain(ks[9], POOL_DIM),
        "w_out": nrm(ks[10], (DEPTH, D_MIX, D_MODEL), D_MIX),
        "g_mix_post": gain(ks[11], D_MODEL),
        "g_ffn2_pre": gain(ks[12], D_MODEL),
        "w2_gate": nrm(ks[13], (DEPTH, D_MODEL, D_FF), D_MODEL),
        "w2_up": nrm(ks[14], (DEPTH, D_MODEL, D_FF), D_MODEL),
        "w2_down": nrm(ks[15], (DEPTH, D_FF, D_MODEL), D_FF),
        "g_ffn2_post": gain(ks[16], D_MODEL),
    }


def reference(x, g_ffn1_pre, w1_gate, w1_up, w1_down, g_ffn1_post, g_mix_pre, w_in,
              w_pool_lin, pool_scale, w_out, g_mix_post, g_ffn2_pre, w2_gate, w2_up,
              w2_down, g_ffn2_post):
    B, S, _ = x.shape
    for l in range(DEPTH):
        x = x + 0.5 * rmsnorm(swiglu(rmsnorm(x, g_ffn1_pre[l]), w1_gate[l], w1_up[l], w1_down[l]),
                              g_ffn1_post[l])
        h = rmsnorm(x, g_mix_pre[l])
        z = h @ w_in[l]
        u = z[..., :POOL_DIM]
        qkv = z[..., POOL_DIM:].reshape(B, S, 3, N_ATTN_HEADS, HEAD_DIM)
        a_pool = pool_mixer(u, w_pool_lin[l], pool_scale[l])
        a_attn = attention_mixer(qkv[:, :, 0], qkv[:, :, 1], qkv[:, :, 2])
        mix = jnp.concatenate([a_pool.astype(x.dtype), a_attn.astype(x.dtype)], axis=-1) @ w_out[l]
        x = x + rmsnorm(mix, g_mix_post[l])
        x = x + 0.5 * rmsnorm(swiglu(rmsnorm(x, g_ffn2_pre[l]), w2_gate[l], w2_up[l], w2_down[l]),
                              g_ffn2_post[l])
    return x
```

```cpp
#include <hip/hip_runtime.h>
#include <hip/hip_cooperative_groups.h>
#include <cstdio>
#include <cstdint>
namespace cg = cooperative_groups;

#define LAS __attribute__((address_space(3)))
typedef unsigned short bf16_t;
typedef short bf16x8 __attribute__((ext_vector_type(8)));
typedef short s16x4 __attribute__((ext_vector_type(4)));
typedef float f32x4 __attribute__((ext_vector_type(4)));
typedef float f32x2 __attribute__((ext_vector_type(2)));
typedef unsigned u32x4 __attribute__((ext_vector_type(4)));
typedef unsigned u32x2 __attribute__((ext_vector_type(2)));
typedef __bf16 bf16v2 __attribute__((ext_vector_type(2)));

constexpr int BATCH = 8, SEQ = 8192, DM = 1024, MROWS = BATCH * SEQ;
constexpr int DFF = 2752, DFFP = 2816;
constexpr int NGU = 2 * DFFP;
constexpr int DIN = 2560, NHEAD = 12;
constexpr int QOFF = 256, KOFF_Z = 1024, VOFF_Z = 1792;
constexpr float RMS_EPS = 1e-6f;

constexpr size_t MiB = 1u << 20;
constexpr size_t WS_WGU1 = 0, WS_WD1 = 12 * MiB, WS_WIN = 18 * MiB, WS_WOUT = 24 * MiB, WS_WGU2 = 26 * MiB, WS_WD2 = 38 * MiB, WS_WLT = 44 * MiB;
constexpr size_t WS_LSE = 45 * MiB;
constexpr size_t WS_H = 64 * MiB;
constexpr size_t WS_Y = 192 * MiB;
constexpr size_t WS_A = 320 * MiB;
constexpr size_t WS_END = 672 * MiB;
static_assert((size_t)NGU * DM * 2 <= 12 * MiB && (size_t)DM * DFFP * 2 <= 6 * MiB && (size_t)DIN * DM * 2 <= 6 * MiB, "weight map");

__device__ __forceinline__ unsigned pk_bf16(float lo, float hi) { f32x2 v = {lo, hi}; bf16v2 c = __builtin_convertvector(v, bf16v2); return __builtin_bit_cast(unsigned, c); }
__device__ __forceinline__ float bf_lo(unsigned u) { return __uint_as_float(u << 16); }
__device__ __forceinline__ float bf_hi(unsigned u) { return __uint_as_float(u & 0xffff0000u); }
__device__ __forceinline__ float wave_sum(float v) {
#pragma unroll
    for (int o = 1; o < 64; o <<= 1) v += __shfl_xor(v, o);
    return v;
}

namespace pg8 {
constexpr int BM = 256, BK = 64, HALF = 128, HTB = HALF * BK * 2, STAGE_BYTES = 8 * HTB, NXCD = 8, WGM = 8;
__host__ __device__ __forceinline__ int lds_byte(int r, int c) { const int st = (r >> 4) * 2 + (c >> 5), rr = r & 15, cc = c & 31, ob = rr * 64 + cc * 2; return st * 1024 + (ob ^ (((ob >> 9) & 1) << 5)); }
__host__ __device__ __forceinline__ void stage_rc(int b, int& R, int& C) { const int st = b / 1024, sb = b % 1024, swz = sb ^ (((sb >> 9) & 1) << 5); R = (st >> 1) * 16 + swz / 64; C = (st & 1) * 32 + (swz % 64) / 2; }
__host__ __device__ __forceinline__ int perm32(int rho) { const int n = rho >> 4, i = rho & 15; return 8 * (i >> 2) + 4 * n + (i & 3); }

struct Unit { int pm, pn; };
struct Gemm { const bf16_t* A; const bf16_t* Bt; int M, N, K; };

struct StaticOrder {
    int nM, nN, nwg, G, c;
    __host__ __device__ void init(int M, int N, int G_, int c_) { nM = M / BM; nN = N / BM; nwg = nM * nN; G = G_; c = c_; }
    __host__ __device__ bool next(int i, Unit& u) const {
        const long L = (long)i * G + c; if (L >= nwg) return false;
        int wgid = (int)L; { const int q = nwg / NXCD, r = nwg % NXCD, xcd = wgid % NXCD, off = wgid / NXCD; wgid = (xcd < r ? xcd * (q + 1) : r * (q + 1) + (xcd - r) * q) + off; }
        const int nig = WGM * nN, gid = wgid / nig, fm = gid * WGM, gsz = (nM - fm) < WGM ? (nM - fm) : WGM;
        u.pm = fm + ((wgid % nig) % gsz); u.pn = (wgid % nig) / gsz; return true;
    }
    __device__ __forceinline__ void a_ready(const Unit&) const {}
    __device__ __forceinline__ void done(const Unit&) const {}
};

struct EpiBf16 {
    static constexpr bool PERM = true, AFTER_DRAIN = false;
    bf16_t* O; int ldc;
    __device__ __forceinline__ void operator()(const f32x4 (&acc)[2][2][4][2], const Unit& u, int wr, int wc, int fr, int fq) const {
        const int row0 = u.pm * BM + wr * 64 + fr; const int col0 = u.pn * BM + wc * 32 + 8 * fq;
#pragma unroll
        for (int ai = 0; ai < 2; ++ai)
#pragma unroll
            for (int m = 0; m < 4; ++m) { bf16_t* rowp = O + (size_t)(row0 + ai * HALF + m * 16) * ldc + col0;
#pragma unroll
                for (int bj = 0; bj < 2; ++bj) { const f32x4 v0 = acc[ai][bj][m][0], v1 = acc[ai][bj][m][1];
                    u32x4 w; w.x = pk_bf16(v0[0], v0[1]); w.y = pk_bf16(v0[2], v0[3]); w.z = pk_bf16(v1[0], v1[1]); w.w = pk_bf16(v1[2], v1[3]);
                    *(u32x4*)(rowp + bj * HALF) = w; } }
    }
};
__device__ __forceinline__ float silu_mul(float g, float u) { const float e = __builtin_amdgcn_exp2f(g * -1.44269504089f); return g * __builtin_amdgcn_rcpf(1.0f + e) * u; }
struct EpiSwiGLU {
    static constexpr bool PERM = true, AFTER_DRAIN = false;
    bf16_t* O; int ldc;
    __device__ __forceinline__ void operator()(const f32x4 (&acc)[2][2][4][2], const Unit& u, int wr, int wc, int fr, int fq) const {
        const int row0 = u.pm * BM + wr * 64 + fr; const int col0 = u.pn * HALF + wc * 32 + 8 * fq;
#pragma unroll
        for (int ai = 0; ai < 2; ++ai)
#pragma unroll
            for (int m = 0; m < 4; ++m) { bf16_t* rowp = O + (size_t)(row0 + ai * HALF + m * 16) * ldc + col0;
                const f32x4 g0 = acc[ai][0][m][0], g1 = acc[ai][0][m][1], u0 = acc[ai][1][m][0], u1 = acc[ai][1][m][1];
                u32x4 w; w.x = pk_bf16(silu_mul(g0[0], u0[0]), silu_mul(g0[1], u0[1])); w.y = pk_bf16(silu_mul(g0[2], u0[2]), silu_mul(g0[3], u0[3]));
                w.z = pk_bf16(silu_mul(g1[0], u1[0]), silu_mul(g1[1], u1[1])); w.w = pk_bf16(silu_mul(g1[2], u1[2]), silu_mul(g1[3], u1[3]));
                *(u32x4*)rowp = w; }
    }
};

template <class Epi, class Sched, bool ALIGN_EPI = false, bool SP2 = false>
__device__ __forceinline__ void gemm_phase(LAS unsigned char* lds, const Gemm g, const Sched& S, const Epi& E) {
    const int tid = threadIdx.x, wid = __builtin_amdgcn_readfirstlane(tid >> 6), lane = tid & 63, wr = wid >> 2, wc = wid & 3, fr = lane & 15, fq = lane >> 4;
    const int K = g.K, nt = K / BK;
    unsigned voffA[2], voffB[2];
#pragma unroll
    for (int i = 0; i < 2; ++i) { int R, C; stage_rc(tid * 16 + i * 8192, R, C); const int Rb = Epi::PERM ? ((R & ~31) + perm32(R & 31)) : R;
        voffA[i] = (unsigned)(R * K + C) * 2u; voffB[i] = (unsigned)(Rb * K + C) * 2u; }
    const size_t kstep = (size_t)(BK * 2);
    const size_t hstep = (size_t)HALF * K * 2;
    const size_t tstep = 2 * hstep;
    const unsigned ldsw = (unsigned)wid * 1024u;
    const int aoff = lds_byte(wr * 64 + fr, fq * 8), boff = lds_byte(wc * 32 + fr, fq * 8);
#define PG8_SA(b, h) (((b) * 2 + (h)) * HTB)
#define PG8_SB(b, h) ((4 + (b) * 2 + (h)) * HTB)
#define PG8_STAGE(bufoff, gbase, voff) do { _Pragma("unroll") for (int _i = 0; _i < 2; ++_i) \
        __builtin_amdgcn_global_load_lds((const unsigned*)((const char*)(gbase) + (voff)[_i]), (LAS unsigned*)(lds + (bufoff) + ldsw + _i * 8192), 16, 0, 0); } while (0)
#define PG8_LDA(dst, b, h) do { _Pragma("unroll") for (int m = 0; m < 4; ++m) _Pragma("unroll") for (int k = 0; k < 2; ++k) dst[m][k] = *(const LAS bf16x8*)(lds + PG8_SA(b, h) + aoff + m * 2048 + k * 1024); } while (0)
#define PG8_LDB(dst, b, h) do { _Pragma("unroll") for (int n = 0; n < 2; ++n) _Pragma("unroll") for (int k = 0; k < 2; ++k) dst[n][k] = *(const LAS bf16x8*)(lds + PG8_SB(b, h) + boff + n * 2048 + k * 1024); } while (0)
#define PG8_MMA(ai, bj, At, Bt) do { __builtin_amdgcn_s_setprio(1); _Pragma("unroll") for (int m = 0; m < 4; ++m) _Pragma("unroll") for (int n = 0; n < 2; ++n) _Pragma("unroll") for (int k = 0; k < 2; ++k) \
        acc[ai][bj][m][n] = __builtin_amdgcn_mfma_f32_16x16x32_bf16(Bt[n][k], At[m][k], acc[ai][bj][m][n], 0, 0, 0); __builtin_amdgcn_s_setprio(0); } while (0)
#define PG8_WAIT_V(n) asm volatile("s_waitcnt vmcnt(" #n ")" ::: "memory")
#define PG8_WAIT_L(n) asm volatile("s_waitcnt lgkmcnt(" #n ")" ::: "memory")
#define PG8_BAR __builtin_amdgcn_s_barrier()
#define PG8_SCHED __builtin_amdgcn_sched_barrier(0)
    Unit cur, nxt; int ui = 0;
    if (!S.next(0, cur)) return;
    f32x4 acc[2][2][4][2];
#pragma unroll
    for (int a = 0; a < 2; ++a)
#pragma unroll
        for (int b = 0; b < 2; ++b)
#pragma unroll
            for (int m = 0; m < 4; ++m)
#pragma unroll
                for (int n = 0; n < 2; ++n) acc[a][b][m][n] = (f32x4){0.f, 0.f, 0.f, 0.f};
    bf16x8 At[4][2], B0[2][2], B1[2][2];
    const char* cA = (const char*)g.A + (size_t)cur.pm * tstep; const char* cB = (const char*)g.Bt + (size_t)cur.pn * tstep;
    S.a_ready(cur);
    if constexpr (SP2) {
        PG8_STAGE(PG8_SB(0, 0), cB, voffB); PG8_STAGE(PG8_SB(0, 1), cB + hstep, voffB); PG8_STAGE(PG8_SA(0, 0), cA, voffA); PG8_STAGE(PG8_SA(0, 1), cA + hstep, voffA);
        if (wr == 1) PG8_BAR;
        PG8_WAIT_V(2); PG8_BAR;
        PG8_STAGE(PG8_SB(1, 0), cB + kstep, voffB); PG8_STAGE(PG8_SA(1, 0), cA + kstep, voffA); PG8_STAGE(PG8_SB(1, 1), cB + hstep + kstep, voffB);
        PG8_WAIT_V(6); PG8_BAR;
    } else {
        PG8_STAGE(PG8_SB(0, 0), cB, voffB); PG8_STAGE(PG8_SA(0, 0), cA, voffA); PG8_STAGE(PG8_SB(0, 1), cB + hstep, voffB); PG8_STAGE(PG8_SA(0, 1), cA + hstep, voffA);
        if (wr == 1) PG8_BAR;
        PG8_WAIT_V(4); PG8_BAR;
        PG8_STAGE(PG8_SB(1, 0), cB + kstep, voffB); PG8_STAGE(PG8_SA(1, 0), cA + kstep, voffA); PG8_STAGE(PG8_SB(1, 1), cB + hstep + kstep, voffB);
        PG8_WAIT_V(6); PG8_BAR;
    }
    for (;;) {
        const bool has_next = S.next(ui + 1, nxt);
        const char* nA = has_next ? (const char*)g.A + (size_t)nxt.pm * tstep : cA; const char* nB = has_next ? (const char*)g.Bt + (size_t)nxt.pn * tstep : cB;
        for (int t = 0; t < nt; t += 2) {
            const bool last = (t == nt - 2);
            const char* a1 = cA + (size_t)(t + 1) * kstep;
            const char* a2 = last ? nA : cA + (size_t)(t + 2) * kstep; const char* b2 = last ? nB : cB + (size_t)(t + 2) * kstep;
            const char* a3 = a2 + kstep; const char* b3 = b2 + kstep;
            if (last && has_next) S.a_ready(nxt);
            if constexpr (SP2) {
            PG8_LDB(B0, 0, 0); PG8_LDB(B1, 0, 1); PG8_SCHED; PG8_LDA(At, 0, 0); PG8_STAGE(PG8_SA(1, 1), a1 + hstep, voffA);
            PG8_WAIT_V(8); PG8_WAIT_L(0); PG8_BAR; PG8_MMA(0, 0, At, B0); PG8_MMA(0, 1, At, B1); PG8_BAR; PG8_SCHED;
            PG8_LDA(At, 0, 1); PG8_STAGE(PG8_SB(0, 0), b2, voffB); PG8_STAGE(PG8_SB(0, 1), b2 + hstep, voffB); PG8_STAGE(PG8_SA(0, 0), a2, voffA);
            PG8_WAIT_V(8); PG8_WAIT_L(0); PG8_BAR; PG8_MMA(1, 0, At, B0); PG8_MMA(1, 1, At, B1); PG8_BAR; PG8_SCHED;
            PG8_LDB(B0, 1, 0); PG8_LDB(B1, 1, 1); PG8_SCHED; PG8_LDA(At, 1, 0); PG8_STAGE(PG8_SA(0, 1), a2 + hstep, voffA);
            PG8_WAIT_V(8); PG8_WAIT_L(0); PG8_BAR; PG8_MMA(0, 0, At, B0); PG8_MMA(0, 1, At, B1); PG8_BAR; PG8_SCHED;
            PG8_LDA(At, 1, 1); PG8_STAGE(PG8_SB(1, 0), b3, voffB); PG8_STAGE(PG8_SB(1, 1), b3 + hstep, voffB); PG8_STAGE(PG8_SA(1, 0), a3, voffA);
            PG8_WAIT_V(8); PG8_WAIT_L(0); PG8_BAR; PG8_MMA(1, 0, At, B0); PG8_MMA(1, 1, At, B1); PG8_BAR; PG8_SCHED;
            } else {
            PG8_LDB(B0, 0, 0); PG8_SCHED; PG8_LDA(At, 0, 0); PG8_STAGE(PG8_SA(1, 1), a1 + hstep, voffA);
            PG8_WAIT_L(8); PG8_BAR; PG8_WAIT_L(0); PG8_MMA(0, 0, At, B0); PG8_BAR; PG8_SCHED;
            PG8_LDB(B1, 0, 1); PG8_STAGE(PG8_SB(0, 0), b2, voffB);
            PG8_BAR; PG8_WAIT_L(0); PG8_MMA(0, 1, At, B1); PG8_BAR;
            PG8_LDA(At, 0, 1); PG8_STAGE(PG8_SA(0, 0), a2, voffA);
            PG8_BAR; PG8_WAIT_L(0); PG8_MMA(1, 0, At, B0); PG8_BAR; PG8_SCHED;
            PG8_STAGE(PG8_SB(0, 1), b2 + hstep, voffB);
            PG8_WAIT_V(6); PG8_BAR; PG8_MMA(1, 1, At, B1); PG8_BAR;
            PG8_LDB(B0, 1, 0); PG8_SCHED; PG8_LDA(At, 1, 0); PG8_STAGE(PG8_SA(0, 1), a2 + hstep, voffA);
            PG8_WAIT_L(8); PG8_BAR; PG8_WAIT_L(0); PG8_MMA(0, 0, At, B0); PG8_BAR; PG8_SCHED;
            PG8_LDB(B1, 1, 1); PG8_STAGE(PG8_SB(1, 0), b3, voffB);
            PG8_BAR; PG8_WAIT_L(0); PG8_MMA(0, 1, At, B1); PG8_BAR;
            PG8_LDA(At, 1, 1); PG8_STAGE(PG8_SA(1, 0), a3, voffA);
            PG8_BAR; PG8_WAIT_L(0); PG8_MMA(1, 0, At, B0); PG8_BAR; PG8_SCHED;
            PG8_STAGE(PG8_SB(1, 1), b3 + hstep, voffB);
            PG8_WAIT_V(6); PG8_BAR; PG8_MMA(1, 1, At, B1); PG8_BAR;
            }
        }
        if constexpr (ALIGN_EPI) { if (wr == 0) PG8_BAR; }
        if constexpr (!Epi::AFTER_DRAIN) { E(acc, cur, wr, wc, fr, fq); S.done(cur); }
        if (!has_next) break;
#pragma unroll
        for (int a = 0; a < 2; ++a)
#pragma unroll
            for (int b = 0; b < 2; ++b)
#pragma unroll
                for (int m = 0; m < 4; ++m)
#pragma unroll
                    for (int n = 0; n < 2; ++n) acc[a][b][m][n] = (f32x4){0.f, 0.f, 0.f, 0.f};
        cur = nxt; cA = nA; cB = nB; ++ui;
        if constexpr (ALIGN_EPI) { if (wr == 1) PG8_BAR; }
    }
    PG8_WAIT_V(0);
    if constexpr (!ALIGN_EPI) { if (wr == 0) PG8_BAR; }
    PG8_BAR;
#undef PG8_SA
#undef PG8_SB
#undef PG8_STAGE
#undef PG8_LDA
#undef PG8_LDB
#undef PG8_MMA
#undef PG8_WAIT_V
#undef PG8_WAIT_L
#undef PG8_BAR
#undef PG8_SCHED
}
}

constexpr int NWAVES = 8, NTHREADS = NWAVES * 64;
constexpr int RING_BYTES = 131072, LDS_BYTES = 147456;

__device__ __forceinline__ void transpose_item(const float* W, int N, bf16_t* WT, int ldt, int k0, int n0, int drow0, LAS float* scr, int lane) {
#pragma unroll 8
    for (int i = 0; i < 32; ++i) { const int kk = 2 * i + (lane >> 5); scr[kk * 33 + (lane & 31)] = W[(size_t)(k0 + kk) * N + n0 + (lane & 31)]; }
    asm volatile("s_waitcnt lgkmcnt(0)" ::: "memory");
    const int c = lane & 7;
#pragma unroll
    for (int j = 0; j < 4; ++j) { const int n = (lane >> 3) + 8 * j; const LAS float* s = scr + (8 * c) * 33 + n;
        u32x4 o; o.x = pk_bf16(s[0 * 33], s[1 * 33]); o.y = pk_bf16(s[2 * 33], s[3 * 33]); o.z = pk_bf16(s[4 * 33], s[5 * 33]); o.w = pk_bf16(s[6 * 33], s[7 * 33]);
        *(u32x4*)(WT + (size_t)(drow0 + n) * ldt + k0 + 8 * c) = o; }
    asm volatile("s_waitcnt lgkmcnt(0)" ::: "memory");
}

struct Args { const float* in[17]; float* out; unsigned char* ws; int ph_lo, ph_hi; };

__device__ __forceinline__ void p0_weights(const Args& a, LAS unsigned char* lds, int gw, int NGW, int wave, int lane, int gtid, int NGT) {
    LAS float* scr = (LAS float*)(lds + wave * 16384);
    unsigned char* ws = a.ws;
    constexpr int I_G = (DM / 64) * (DFF / 32);
    constexpr int I_D = (DFF / 64) * (DM / 32);
    constexpr int I_IN = (DM / 64) * (DIN / 32);
    constexpr int I_OUT = (DM / 64) * (DM / 32);
    constexpr int NITEMS = 2 * (2 * I_G + I_D) + I_IN + I_OUT;
    for (int it = gw; it < NITEMS; it += NGW) {
        int r = it;
        bool done = false;
#pragma unroll
        for (int f = 0; f < 2; ++f) {
            if (done) break;
            const float* Wg = a.in[f ? 13 : 2]; const float* Wu = a.in[f ? 14 : 3]; const float* Wd = a.in[f ? 15 : 4];
            bf16_t* WGU = (bf16_t*)(ws + (f ? WS_WGU2 : WS_WGU1)); bf16_t* WD = (bf16_t*)(ws + (f ? WS_WD2 : WS_WD1));
            if (r < 2 * I_G) { const int up = r >= I_G; const int q = up ? r - I_G : r; const int nblk = DFF / 32, kb = q / nblk, nb = q % nblk, n0 = nb * 32;
                transpose_item(up ? Wu : Wg, DFF, WGU, DM, kb * 64, n0, 256 * (n0 >> 7) + (n0 & 127) + (up ? 128 : 0), scr, lane); done = true; break; }
            r -= 2 * I_G;
            if (r < I_D) { const int nblk = DM / 32, kb = r / nblk, nb = r % nblk; transpose_item(Wd, DM, WD, DFFP, kb * 64, nb * 32, nb * 32, scr, lane); done = true; break; }
            r -= I_D;
        }
        if (done) continue;
        if (r < I_IN) { const int nblk = DIN / 32, kb = r / nblk, nb = r % nblk; transpose_item(a.in[7], DIN, (bf16_t*)(ws + WS_WIN), DM, kb * 64, nb * 32, nb * 32, scr, lane); continue; }
        r -= I_IN;
        { const int nblk = DM / 32, kb = r / nblk, nb = r % nblk; transpose_item(a.in[10], DM, (bf16_t*)(ws + WS_WOUT), DM, kb * 64, nb * 32, nb * 32, scr, lane); }
    }
    for (int f = 0; f < 2; ++f) {
        u32x4* WGU = (u32x4*)(ws + (f ? WS_WGU2 : WS_WGU1)); u32x4* WD = (u32x4*)(ws + (f ? WS_WD2 : WS_WD1));
        for (int i = gtid; i < 128 * 128; i += NGT) { const int pr = i >> 7, c = i & 127; const int row = 256 * 21 + (pr < 64 ? 64 + pr : 128 + pr); WGU[(size_t)row * (DM / 8) + c] = (u32x4){0u, 0u, 0u, 0u}; }
        for (int i = gtid; i < 1024 * 8; i += NGT) { const int row = i >> 3, c = i & 7; WD[(size_t)row * (DFFP / 8) + (DFF / 8) + c] = (u32x4){0u, 0u, 0u, 0u}; }
    }
    { bf16_t* wlt = (bf16_t*)(ws + WS_WLT); const float* wl = a.in[8];
      for (int i = gtid; i < 4 * 64 * 64; i += NGT) { const int g = i >> 12, e = (i >> 6) & 63, c = i & 63; wlt[i] = (bf16_t)(pk_bf16(wl[g * 4096 + c * 64 + e], 0.f) & 0xffffu); } }
}

template <bool HAS_Y, bool WRITE_X, bool WRITE_H>
__device__ __forceinline__ void norm_pass(const float* xin, const bf16_t* y, const float* gpost, float coef, float* xout, const float* gnext, bf16_t* hout, int gw, int NGW, int lane) {
    f32x4 gp[4], gn[4];
#pragma unroll
    for (int j = 0; j < 4; ++j) { gp[j] = HAS_Y ? *(const f32x4*)(gpost + 4 * lane + 256 * j) : (f32x4){0.f, 0.f, 0.f, 0.f}; gn[j] = WRITE_H ? *(const f32x4*)(gnext + 4 * lane + 256 * j) : (f32x4){0.f, 0.f, 0.f, 0.f}; }
    for (int row = gw; row < MROWS; row += NGW) {
        const f32x4* xr = (const f32x4*)(xin + (size_t)row * DM) + lane;
        f32x4 v[4];
#pragma unroll
        for (int j = 0; j < 4; ++j) v[j] = xr[64 * j];
        if constexpr (HAS_Y) {
            const u32x2* yr = (const u32x2*)(y + (size_t)row * DM) + lane;
            f32x4 yv[4]; float ss = 0.f;
#pragma unroll
            for (int j = 0; j < 4; ++j) { const u32x2 u = yr[64 * j]; yv[j] = (f32x4){bf_lo(u.x), bf_hi(u.x), bf_lo(u.y), bf_hi(u.y)}; ss += (yv[j].x * yv[j].x + yv[j].y * yv[j].y) + (yv[j].z * yv[j].z + yv[j].w * yv[j].w); }
            const float r = coef * __builtin_amdgcn_rsqf(wave_sum(ss) * (1.0f / DM) + RMS_EPS);
#pragma unroll
            for (int j = 0; j < 4; ++j) v[j] = v[j] + yv[j] * gp[j] * r;
        }
        if constexpr (WRITE_X) {
            f32x4* xo = (f32x4*)(xout + (size_t)row * DM) + lane;
#pragma unroll
            for (int j = 0; j < 4; ++j) xo[64 * j] = v[j];
        }
        if constexpr (WRITE_H) {
            float ss = 0.f;
#pragma unroll
            for (int j = 0; j < 4; ++j) ss += (v[j].x * v[j].x + v[j].y * v[j].y) + (v[j].z * v[j].z + v[j].w * v[j].w);
            const float r = __builtin_amdgcn_rsqf(wave_sum(ss) * (1.0f / DM) + RMS_EPS);
            u32x2* ho = (u32x2*)(hout + (size_t)row * DM) + lane;
#pragma unroll
            for (int j = 0; j < 4; ++j) { const f32x4 h = v[j] * gn[j] * r; ho[64 * j] = (u32x2){pk_bf16(h.x, h.y), pk_bf16(h.z, h.w)}; }
        }
    }
}

__device__ __forceinline__ void pool_phase(const bf16_t* z, const bf16_t* wlt, const float* pscale, bf16_t* mix, int gw, int NGW, int lane) {
    const int fr = lane & 15, fq = lane >> 4;
    for (int task = gw; task < (MROWS / 16) * 4; task += NGW) {
        const int strip = task >> 2, gi = task & 3, row = strip * 16 + fr, t = row & (SEQ - 1), bbase = row - t;
        const int hw = 1 << gi;
        const int lo = max(t - hw, 0), hi = min(t + hw, SEQ);
        const float inv = 1.0f / (float)(hi - lo);
        bf16x8 yb[2];
#pragma unroll
        for (int kk = 0; kk < 2; ++kk) {
            const int c0 = gi * 64 + 8 * fq + 32 * kk;
            float s[8];
#pragma unroll
            for (int e = 0; e < 8; ++e) s[e] = 0.f;
            for (int tt = lo; tt < hi; ++tt) { const u32x4 u = *(const u32x4*)(z + (size_t)(bbase + tt) * DIN + c0);
                s[0] += bf_lo(u.x); s[1] += bf_hi(u.x); s[2] += bf_lo(u.y); s[3] += bf_hi(u.y); s[4] += bf_lo(u.z); s[5] += bf_hi(u.z); s[6] += bf_lo(u.w); s[7] += bf_hi(u.w); }
            const u32x4 u = *(const u32x4*)(z + (size_t)row * DIN + c0);
            u32x4 p; p.x = pk_bf16(s[0] * inv - bf_lo(u.x), s[1] * inv - bf_hi(u.x)); p.y = pk_bf16(s[2] * inv - bf_lo(u.y), s[3] * inv - bf_hi(u.y));
            p.z = pk_bf16(s[4] * inv - bf_lo(u.z), s[5] * inv - bf_hi(u.z)); p.w = pk_bf16(s[6] * inv - bf_lo(u.w), s[7] * inv - bf_hi(u.w));
            yb[kk] = __builtin_bit_cast(bf16x8, p);
        }
#pragma unroll
        for (int eb = 0; eb < 4; ++eb) {
            f32x4 acc = {0.f, 0.f, 0.f, 0.f};
#pragma unroll
            for (int kk = 0; kk < 2; ++kk) { const bf16x8 wa = *(const bf16x8*)(wlt + (size_t)gi * 4096 + (16 * eb + fr) * 64 + 8 * fq + 32 * kk);
                acc = __builtin_amdgcn_mfma_f32_16x16x32_bf16(wa, yb[kk], acc, 0, 0, 0); }
            const f32x4 sc = *(const f32x4*)(pscale + gi * 64 + 16 * eb + 4 * fq);
            acc = acc * sc;
            *(u32x2*)(mix + (size_t)row * DM + gi * 64 + 16 * eb + 4 * fq) = (u32x2){pk_bf16(acc.x, acc.y), pk_bf16(acc.z, acc.w)};
        }
    }
}

constexpr int AT_PITCH = 144, AT_ROWS = 272, AT_KOFF = 0, AT_VOFF = AT_ROWS * AT_PITCH;
__device__ __forceinline__ void attn_phase(LAS unsigned char* lds, const bf16_t* z, bf16_t* mix, float* lse, int G, int bid, int tid) {
    const int lane = tid & 63, w = __builtin_amdgcn_readfirstlane(tid >> 6), fr = lane & 15, fq = lane >> 4;
    for (int i = tid; i < 16 * AT_PITCH / 4; i += NTHREADS) { ((LAS unsigned*)(lds + AT_VOFF + 256 * AT_PITCH))[i] = 0u; ((LAS unsigned*)(lds + AT_KOFF + 256 * AT_PITCH))[i] = 0u; }
    for (int unit = bid; unit < BATCH * NHEAD * 64; unit += G) {
        const int bh = unit >> 6, j = unit & 63, b = bh / NHEAD, h = bh - b * NHEAD, g = h >> 2;
        const int dsh = 2 * g, L = SEQ >> dsh;
        const int r = j >> (6 - dsh), c = j & ((64 >> dsh) - 1), n0 = c * 128;
        const size_t rowbase = (size_t)b * SEQ + r;
        __syncthreads();
        {
            u32x4 kv[4], vv[4];
#pragma unroll
            for (int i = 0; i < 4; ++i) { const int id = tid + NTHREADS * i, row = id >> 3, ch = id & 7, n = n0 - 64 + row;
                kv[i] = (u32x4){0u, 0u, 0u, 0u}; vv[i] = kv[i];
                if (n >= 0 && n < L) { const bf16_t* src = z + (rowbase + ((size_t)n << dsh)) * DIN + h * 64 + ch * 8; kv[i] = *(const u32x4*)(src + KOFF_Z); vv[i] = *(const u32x4*)(src + VOFF_Z); } }
#pragma unroll
            for (int i = 0; i < 4; ++i) { const int id = tid + NTHREADS * i, row = id >> 3, ch = id & 7;
                *(LAS u32x4*)(lds + AT_KOFF + row * AT_PITCH + ch * 16) = kv[i]; *(LAS u32x4*)(lds + AT_VOFF + row * AT_PITCH + ch * 16) = vv[i]; }
        }
        const int nq = n0 + 16 * w + fr;
        const size_t qrow = rowbase + ((size_t)nq << dsh);
        bf16x8 qf[2];
#pragma unroll
        for (int kk = 0; kk < 2; ++kk) qf[kk] = *(const bf16x8*)(z + qrow * DIN + QOFF + h * 64 + 8 * fq + 32 * kk);
        __syncthreads();
        f32x4 s[9];
#pragma unroll
        for (int kt = 0; kt < 9; ++kt) {
            const LAS unsigned char* kp = lds + AT_KOFF + (16 * w + 16 * kt + fr) * AT_PITCH + 16 * fq;
            const bf16x8 a0 = *(const LAS bf16x8*)kp, a1 = *(const LAS bf16x8*)(kp + 64);
            f32x4 acc = {0.f, 0.f, 0.f, 0.f};
            acc = __builtin_amdgcn_mfma_f32_16x16x32_bf16(a0, qf[0], acc, 0, 0, 0);
            acc = __builtin_amdgcn_mfma_f32_16x16x32_bf16(a1, qf[1], acc, 0, 0, 0);
            s[kt] = acc;
        }
        const float c1 = 0.125f * 1.44269504089f;
        const float c2 = exp2f(-8.0f * (float)(h + 1) / 12.0f) * (float)(1 << dsh) * 1.44269504089f;
        float mx = -INFINITY;
#pragma unroll
        for (int kt = 0; kt < 9; ++kt)
#pragma unroll
            for (int e = 0; e < 4; ++e) {
                const int rel = 16 * kt + 4 * fq + e - 64 - fr;
                const int nk = n0 + 16 * w + fr + rel;
                const bool ok = (rel >= -64) && (rel <= 64) && (nk >= 0) && (nk < L);
                const float v = ok ? s[kt][e] * c1 - c2 * (float)(rel < 0 ? -rel : rel) : -INFINITY;
                s[kt][e] = v; mx = fmaxf(mx, v);
            }
        mx = fmaxf(mx, __shfl_xor(mx, 16)); mx = fmaxf(mx, __shfl_xor(mx, 32));
        float sum = 0.f;
#pragma unroll
        for (int kt = 0; kt < 9; ++kt)
#pragma unroll
            for (int e = 0; e < 4; ++e) { const float p = __builtin_amdgcn_exp2f(s[kt][e] - mx); s[kt][e] = p; sum += p; }
        sum += __shfl_xor(sum, 16); sum += __shfl_xor(sum, 32);
        f32x4 o[4];
#pragma unroll
        for (int db = 0; db < 4; ++db) o[db] = (f32x4){0.f, 0.f, 0.f, 0.f};
        const int tq = (lane & 15) >> 2, tp = lane & 3;
#pragma unroll
        for (int cc = 0; cc < 5; ++cc) {
            u32x4 pp; pp.x = pk_bf16(s[2 * cc][0], s[2 * cc][1]); pp.y = pk_bf16(s[2 * cc][2], s[2 * cc][3]);
            if (cc < 4) { pp.z = pk_bf16(s[2 * cc + 1][0], s[2 * cc + 1][1]); pp.w = pk_bf16(s[2 * cc + 1][2], s[2 * cc + 1][3]); } else { pp.z = 0u; pp.w = 0u; }
            const bf16x8 pb = __builtin_bit_cast(bf16x8, pp);
            const LAS unsigned char* vp = lds + AT_VOFF + (16 * w + 32 * cc + 4 * fq + tq) * AT_PITCH + 8 * tp;
#pragma unroll
            for (int db = 0; db < 4; ++db) {
                const s16x4 v0 = __builtin_amdgcn_ds_read_tr16_b64_v4i16((LAS s16x4*)(vp + 32 * db));
                const s16x4 v1 = __builtin_amdgcn_ds_read_tr16_b64_v4i16((LAS s16x4*)(vp + 16 * AT_PITCH + 32 * db));
                const bf16x8 va = {v0[0], v0[1], v0[2], v0[3], v1[0], v1[1], v1[2], v1[3]};
                o[db] = __builtin_amdgcn_mfma_f32_16x16x32_bf16(va, pb, o[db], 0, 0, 0);
            }
        }
        const float inv = 1.0f / sum;
        bf16_t* op = mix + qrow * DM + 256 + h * 64 + 4 * fq;
#pragma unroll
        for (int db = 0; db < 4; ++db) { const f32x4 v = o[db] * inv; *(u32x2*)(op + 16 * db) = (u32x2){pk_bf16(v.x, v.y), pk_bf16(v.z, v.w)}; }
        if (fq == 0) lse[qrow * NHEAD + h] = (mx + __builtin_amdgcn_logf(sum)) * 0.69314718056f;
    }
    __syncthreads();
}

__device__ __forceinline__ void alpha_pass(bf16_t* mix, const float* lse, int gw, int NGW, int lane) {
    const int hg = lane >> 4;
    for (int row = gw; row < MROWS; row += NGW) {
        const float* lr = lse + (size_t)row * NHEAD;
        const float l0 = lr[hg], l1 = lr[4 + hg], l2 = lr[8 + hg];
        const float m = fmaxf(l0, fmaxf(l1, l2));
        const float e0 = __expf(l0 - m), e1 = __expf(l1 - m), e2 = __expf(l2 - m);
        const float inv = 1.0f / (e0 + e1 + e2);
        const float al[3] = {e0 * inv, e1 * inv, e2 * inv};
        u32x2* p = (u32x2*)(mix + (size_t)row * DM + 256) + lane;
#pragma unroll
        for (int i = 0; i < 3; ++i) { const u32x2 u = p[64 * i]; const float a = al[i];
            p[64 * i] = (u32x2){pk_bf16(bf_lo(u.x) * a, bf_hi(u.x) * a), pk_bf16(bf_lo(u.y) * a, bf_hi(u.y) * a)}; }
    }
}

__global__ void __launch_bounds__(NTHREADS, 2) fwd_kernel(Args args) {
    extern __shared__ __attribute__((aligned(16))) unsigned char lds_raw[];
    LAS unsigned char* lds = (LAS unsigned char*)lds_raw;
    cg::grid_group grid = cg::this_grid();
    const int tid = threadIdx.x, lane = tid & 63, wave = __builtin_amdgcn_readfirstlane(tid >> 6);
    const int G = gridDim.x, bid = blockIdx.x;
    const int gw = bid * NWAVES + wave, NGW = G * NWAVES, gtid = bid * NTHREADS + tid, NGT = G * NTHREADS;
    unsigned char* ws = args.ws;
    bf16_t* WGU1 = (bf16_t*)(ws + WS_WGU1); bf16_t* WD1 = (bf16_t*)(ws + WS_WD1); bf16_t* WIN = (bf16_t*)(ws + WS_WIN); bf16_t* WOUT = (bf16_t*)(ws + WS_WOUT);
    bf16_t* WGU2 = (bf16_t*)(ws + WS_WGU2); bf16_t* WD2 = (bf16_t*)(ws + WS_WD2); bf16_t* WLT = (bf16_t*)(ws + WS_WLT);
    float* LSE = (float*)(ws + WS_LSE);
    bf16_t* HB = (bf16_t*)(ws + WS_H); bf16_t* YB = (bf16_t*)(ws + WS_Y); bf16_t* AB = (bf16_t*)(ws + WS_A); bf16_t* ZB = AB;
    const float* x = args.in[0]; float* out = args.out;
    const int lo = args.ph_lo, hi = args.ph_hi;
#define IN(k) (lo <= (k) && (k) < hi)
#define SEAM(k) do { if (IN(k) && IN((k) + 1)) grid.sync(); } while (0)

    if (IN(0)) { p0_weights(args, lds, gw, NGW, wave, lane, gtid, NGT);
        norm_pass<false, false, true>(x, nullptr, nullptr, 0.f, nullptr, args.in[1], HB, gw, NGW, lane); }
    SEAM(0);
    if (IN(1)) { pg8::Gemm g{HB, WGU1, MROWS, NGU, DM}; pg8::StaticOrder S; S.init(MROWS, NGU, G, bid); pg8::EpiSwiGLU E{AB, DFFP};
        pg8::gemm_phase<pg8::EpiSwiGLU, pg8::StaticOrder, true, true>(lds, g, S, E); }
    SEAM(1);
    if (IN(2)) { pg8::Gemm g{AB, WD1, MROWS, DM, DFFP}; pg8::StaticOrder S; S.init(MROWS, DM, G, bid); pg8::EpiBf16 E{YB, DM};
        pg8::gemm_phase<pg8::EpiBf16, pg8::StaticOrder, true, true>(lds, g, S, E); }
    SEAM(2);
    if (IN(3)) norm_pass<true, true, true>(x, YB, args.in[5], 0.5f, out, args.in[6], HB, gw, NGW, lane);
    SEAM(3);
    if (IN(4)) { pg8::Gemm g{HB, WIN, MROWS, DIN, DM}; pg8::StaticOrder S; S.init(MROWS, DIN, G, bid); pg8::EpiBf16 E{ZB, DIN};
        pg8::gemm_phase<pg8::EpiBf16, pg8::StaticOrder, true, true>(lds, g, S, E); }
    SEAM(4);
    if (IN(5)) { pool_phase(ZB, WLT, args.in[9], HB, gw, NGW, lane); attn_phase(lds, ZB, HB, LSE, G, bid, tid); }
    SEAM(5);
    if (IN(6)) alpha_pass(HB, LSE, gw, NGW, lane);
    SEAM(6);
    if (IN(7)) { pg8::Gemm g{HB, WOUT, MROWS, DM, DM}; pg8::StaticOrder S; S.init(MROWS, DM, G, bid); pg8::EpiBf16 E{YB, DM};
        pg8::gemm_phase<pg8::EpiBf16, pg8::StaticOrder, true, true>(lds, g, S, E); }
    SEAM(7);
    if (IN(8)) norm_pass<true, true, true>(out, YB, args.in[11], 1.0f, out, args.in[12], HB, gw, NGW, lane);
    SEAM(8);
    if (IN(9)) { pg8::Gemm g{HB, WGU2, MROWS, NGU, DM}; pg8::StaticOrder S; S.init(MROWS, NGU, G, bid); pg8::EpiSwiGLU E{AB, DFFP};
        pg8::gemm_phase<pg8::EpiSwiGLU, pg8::StaticOrder, true, true>(lds, g, S, E); }
    SEAM(9);
    if (IN(10)) { pg8::Gemm g{AB, WD2, MROWS, DM, DFFP}; pg8::StaticOrder S; S.init(MROWS, DM, G, bid); pg8::EpiBf16 E{YB, DM};
        pg8::gemm_phase<pg8::EpiBf16, pg8::StaticOrder, true, true>(lds, g, S, E); }
    SEAM(10);
    if (IN(11)) norm_pass<true, true, false>(out, YB, args.in[16], 0.5f, out, nullptr, nullptr, gw, NGW, lane);
#undef IN
#undef SEAM
}

constexpr int NPHASES = 12;
#ifndef MK_PER_PHASE
#define MK_PER_PHASE 0
#endif

extern "C" void kernel_launch(void* const* d_in, const int* in_sizes, int n_in, void* d_out, int out_size, void* d_ws, size_t ws_size, hipStream_t stream) {
    static int grid = 0;
    if (grid == 0) {
        if (n_in != 17 || out_size != MROWS * DM || ws_size < WS_END) { fprintf(stderr, "kernel_launch: unexpected shapes (n_in %d out %d ws %zu)\n", n_in, out_size, ws_size); grid = -1; return; }
        int dev = 0, cus = 0, per_cu = 0;
        hipGetDevice(&dev);
        hipDeviceGetAttribute(&cus, hipDeviceAttributeMultiprocessorCount, dev);
        if (hipFuncSetAttribute((const void*)fwd_kernel, hipFuncAttributeMaxDynamicSharedMemorySize, LDS_BYTES) != hipSuccess) { fprintf(stderr, "kernel_launch: hipFuncSetAttribute failed\n"); grid = -1; return; }
        if (hipOccupancyMaxActiveBlocksPerMultiprocessor(&per_cu, (const void*)fwd_kernel, NTHREADS, LDS_BYTES) != hipSuccess || per_cu < 1) { fprintf(stderr, "kernel_launch: occupancy query gave %d\n", per_cu); per_cu = 1; }
        (void)hipGetLastError();
        grid = cus * per_cu;
        fprintf(stderr, "kernel_launch: cus %d per_cu %d grid %d\n", cus, per_cu, grid);
    }
    if (grid < 0) return;
    Args a{};
    for (int i = 0; i < 17; ++i) a.in[i] = (const float*)d_in[i];
    a.out = (float*)d_out; a.ws = (unsigned char*)d_ws;
#if MK_PER_PHASE
    for (int p = 0; p < NPHASES; ++p) { a.ph_lo = p; a.ph_hi = p + 1; hipLaunchKernelGGL(fwd_kernel, dim3(grid), dim3(NTHREADS), LDS_BYTES, stream, a); }
#else
    a.ph_lo = 0; a.ph_hi = NPHASES;
    void* kargs[] = {&a};
    hipError_t e = hipLaunchCooperativeKernel((const void*)fwd_kernel, dim3(grid), dim3(NTHREADS), kargs, LDS_BYTES, stream);
    if (e != hipSuccess) fprintf(stderr, "kernel_launch: cooperative launch failed: %s (grid %d)\n", hipGetErrorString(e), grid);
#endif
}
```

```cpp
#include <hip/hip_runtime.h>
#include <hip/hip_cooperative_groups.h>
#include <cstdio>
#include <cstdint>
namespace cg = cooperative_groups;

#define LAS __attribute__((address_space(3)))
typedef unsigned short bf16_t;
typedef short bf16x8 __attribute__((ext_vector_type(8)));
typedef short s16x4 __attribute__((ext_vector_type(4)));
typedef float f32x4 __attribute__((ext_vector_type(4)));
typedef float f32x2 __attribute__((ext_vector_type(2)));
typedef unsigned u32x4 __attribute__((ext_vector_type(4)));
typedef unsigned u32x2 __attribute__((ext_vector_type(2)));
typedef __bf16 bf16v2 __attribute__((ext_vector_type(2)));

constexpr int BATCH = 8, SEQ = 8192, DM = 1024, MROWS = BATCH * SEQ;
constexpr int DFF = 2752, DFFP = 2816;
constexpr int NGU = 2 * DFFP;
constexpr int DIN = 2560, NHEAD = 12;
constexpr int QOFF = 256, KOFF_Z = 1024, VOFF_Z = 1792;
constexpr float RMS_EPS = 1e-6f;

constexpr size_t MiB = 1u << 20;
constexpr size_t WS_WGU1 = 0, WS_WD1 = 12 * MiB, WS_WIN = 18 * MiB, WS_WOUT = 24 * MiB, WS_WGU2 = 26 * MiB, WS_WD2 = 38 * MiB, WS_WLT = 44 * MiB;
constexpr size_t WS_LSE = 45 * MiB;
constexpr size_t WS_H = 64 * MiB;
constexpr size_t WS_Y = 192 * MiB;
constexpr size_t WS_A = 320 * MiB;
constexpr size_t WS_END = 672 * MiB;
static_assert((size_t)NGU * DM * 2 <= 12 * MiB && (size_t)DM * DFFP * 2 <= 6 * MiB && (size_t)DIN * DM * 2 <= 6 * MiB, "weight map");

__device__ __forceinline__ unsigned pk_bf16(float lo, float hi) { f32x2 v = {lo, hi}; bf16v2 c = __builtin_convertvector(v, bf16v2); return __builtin_bit_cast(unsigned, c); }
__device__ __forceinline__ float bf_lo(unsigned u) { return __uint_as_float(u << 16); }
__device__ __forceinline__ float bf_hi(unsigned u) { return __uint_as_float(u & 0xffff0000u); }
__device__ __forceinline__ float wave_sum(float v) {
#pragma unroll
    for (int o = 1; o < 64; o <<= 1) v += __shfl_xor(v, o);
    return v;
}

namespace pg8 {
constexpr int BM = 256, BK = 64, HALF = 128, HTB = HALF * BK * 2, STAGE_BYTES = 8 * HTB, NXCD = 8, WGM = 8;
__host__ __device__ __forceinline__ int lds_byte(int r, int c) { const int st = (r >> 4) * 2 + (c >> 5), rr = r & 15, cc = c & 31, ob = rr * 64 + cc * 2; return st * 1024 + (ob ^ (((ob >> 9) & 1) << 5)); }
__host__ __device__ __forceinline__ void stage_rc(int b, int& R, int& C) { const int st = b / 1024, sb = b % 1024, swz = sb ^ (((sb >> 9) & 1) << 5); R = (st >> 1) * 16 + swz / 64; C = (st & 1) * 32 + (swz % 64) / 2; }
__host__ __device__ __forceinline__ int perm32(int rho) { const int n = rho >> 4, i = rho & 15; return 8 * (i >> 2) + 4 * n + (i & 3); }

struct Unit { int pm, pn; };
struct Gemm { const bf16_t* A; const bf16_t* Bt; int M, N, K; };

struct StaticOrder {
    int nM, nN, nwg, G, c;
    __host__ __device__ void init(int M, int N, int G_, int c_) { nM = M / BM; nN = N / BM; nwg = nM * nN; G = G_; c = c_; }
    __host__ __device__ bool next(int i, Unit& u) const {
        const long L = (long)i * G + c; if (L >= nwg) return false;
        int wgid = (int)L; { const int q = nwg / NXCD, r = nwg % NXCD, xcd = wgid % NXCD, off = wgid / NXCD; wgid = (xcd < r ? xcd * (q + 1) : r * (q + 1) + (xcd - r) * q) + off; }
        const int nig = WGM * nN, gid = wgid / nig, fm = gid * WGM, gsz = (nM - fm) < WGM ? (nM - fm) : WGM;
        u.pm = fm + ((wgid % nig) % gsz); u.pn = (wgid % nig) / gsz; return true;
    }
    __device__ __forceinline__ void a_ready(const Unit&) const {}
    __device__ __forceinline__ void done(const Unit&) const {}
};

constexpr int EPI_PITCH = 144, EPI_WAVE_BYTES = 16 * EPI_PITCH;
struct EpiBf16 {
    static constexpr bool PERM = true, AFTER_DRAIN = false;
    bf16_t* O; int ldc;
    __device__ __forceinline__ void operator()(const f32x4 (&acc)[2][2][4][2], const Unit& u, int wr, int wc, int fr, int fq, LAS unsigned char* stg) const {
        const int lane = fr + 16 * fq, r4 = lane >> 2, c4 = lane & 3;
        bf16_t* base = O + (size_t)(u.pm * BM + wr * 64 + r4) * ldc + u.pn * BM + wc * 32 + c4 * 8;
        LAS unsigned char* wp = stg + fr * EPI_PITCH + fq * 16; const LAS unsigned char* rp = stg + r4 * EPI_PITCH + c4 * 16;
#pragma unroll
        for (int ai = 0; ai < 2; ++ai)
#pragma unroll
            for (int m = 0; m < 4; ++m) {
#pragma unroll
                for (int bj = 0; bj < 2; ++bj) { const f32x4 v0 = acc[ai][bj][m][0], v1 = acc[ai][bj][m][1];
                    u32x4 w; w.x = pk_bf16(v0[0], v0[1]); w.y = pk_bf16(v0[2], v0[3]); w.z = pk_bf16(v1[0], v1[1]); w.w = pk_bf16(v1[2], v1[3]);
                    *(LAS u32x4*)(wp + bj * 64) = w; }
                bf16_t* rowp = base + (size_t)(ai * HALF + m * 16) * ldc;
#pragma unroll
                for (int bj = 0; bj < 2; ++bj) { const u32x4 v = *(const LAS u32x4*)(rp + bj * 64); *(u32x4*)(rowp + bj * HALF) = v; }
            }
    }
};
__device__ __forceinline__ float silu_mul(float g, float u) { const float e = __builtin_amdgcn_exp2f(g * -1.44269504089f); return g * __builtin_amdgcn_rcpf(1.0f + e) * u; }
struct EpiSwiGLU {
    static constexpr bool PERM = true, AFTER_DRAIN = false;
    bf16_t* O; int ldc;
    __device__ __forceinline__ void operator()(const f32x4 (&acc)[2][2][4][2], const Unit& u, int wr, int wc, int fr, int fq, LAS unsigned char* stg) const {
        const int lane = fr + 16 * fq, r4 = lane >> 2, c4 = lane & 3;
        bf16_t* base = O + (size_t)(u.pm * BM + wr * 64 + r4) * ldc + u.pn * HALF + wc * 32 + c4 * 8;
        LAS unsigned char* wp = stg + fr * EPI_PITCH + fq * 16; const LAS unsigned char* rp = stg + r4 * EPI_PITCH + c4 * 16;
#pragma unroll
        for (int ai = 0; ai < 2; ++ai)
#pragma unroll
            for (int mp = 0; mp < 2; ++mp) {
#pragma unroll
                for (int mm = 0; mm < 2; ++mm) { const int m = 2 * mp + mm;
                    const f32x4 g0 = acc[ai][0][m][0], g1 = acc[ai][0][m][1], u0 = acc[ai][1][m][0], u1 = acc[ai][1][m][1];
                    u32x4 w; w.x = pk_bf16(silu_mul(g0[0], u0[0]), silu_mul(g0[1], u0[1])); w.y = pk_bf16(silu_mul(g0[2], u0[2]), silu_mul(g0[3], u0[3]));
                    w.z = pk_bf16(silu_mul(g1[0], u1[0]), silu_mul(g1[1], u1[1])); w.w = pk_bf16(silu_mul(g1[2], u1[2]), silu_mul(g1[3], u1[3]));
                    *(LAS u32x4*)(wp + mm * 64) = w; }
#pragma unroll
                for (int mm = 0; mm < 2; ++mm) { const u32x4 v = *(const LAS u32x4*)(rp + mm * 64); *(u32x4*)(base + (size_t)(ai * HALF + (2 * mp + mm) * 16) * ldc) = v; }
            }
    }
};

template <class Epi, class Sched, bool ALIGN_EPI = false, bool SP2 = false>
__device__ __forceinline__ void gemm_phase(LAS unsigned char* lds, const Gemm g, const Sched& S, const Epi& E) {
    const int tid = threadIdx.x, wid = __builtin_amdgcn_readfirstlane(tid >> 6), lane = tid & 63, wr = wid >> 2, wc = wid & 3, fr = lane & 15, fq = lane >> 4;
    const int K = g.K, nt = K / BK;
    unsigned voffA[2], voffB[2];
#pragma unroll
    for (int i = 0; i < 2; ++i) { int R, C; stage_rc(tid * 16 + i * 8192, R, C); const int Rb = Epi::PERM ? ((R & ~31) + perm32(R & 31)) : R;
        voffA[i] = (unsigned)(R * K + C) * 2u; voffB[i] = (unsigned)(Rb * K + C) * 2u; }
    const size_t kstep = (size_t)(BK * 2);
    const size_t hstep = (size_t)HALF * K * 2;
    const size_t tstep = 2 * hstep;
    const unsigned ldsw = (unsigned)wid * 1024u;
    const int aoff = lds_byte(wr * 64 + fr, fq * 8), boff = lds_byte(wc * 32 + fr, fq * 8);
#define PG8_SA(b, h) (((b) * 2 + (h)) * HTB)
#define PG8_SB(b, h) ((4 + (b) * 2 + (h)) * HTB)
#define PG8_STAGE(bufoff, gbase, voff) do { _Pragma("unroll") for (int _i = 0; _i < 2; ++_i) \
        __builtin_amdgcn_global_load_lds((const unsigned*)((const char*)(gbase) + (voff)[_i]), (LAS unsigned*)(lds + (bufoff) + ldsw + _i * 8192), 16, 0, 0); } while (0)
#define PG8_LDA(dst, b, h) do { _Pragma("unroll") for (int m = 0; m < 4; ++m) _Pragma("unroll") for (int k = 0; k < 2; ++k) dst[m][k] = *(const LAS bf16x8*)(lds + PG8_SA(b, h) + aoff + m * 2048 + k * 1024); } while (0)
#define PG8_LDB(dst, b, h) do { _Pragma("unroll") for (int n = 0; n < 2; ++n) _Pragma("unroll") for (int k = 0; k < 2; ++k) dst[n][k] = *(const LAS bf16x8*)(lds + PG8_SB(b, h) + boff + n * 2048 + k * 1024); } while (0)
#define PG8_MMA(ai, bj, At, Bt) do { __builtin_amdgcn_s_setprio(1); _Pragma("unroll") for (int m = 0; m < 4; ++m) _Pragma("unroll") for (int n = 0; n < 2; ++n) _Pragma("unroll") for (int k = 0; k < 2; ++k) \
        acc[ai][bj][m][n] = __builtin_amdgcn_mfma_f32_16x16x32_bf16(Bt[n][k], At[m][k], acc[ai][bj][m][n], 0, 0, 0); __builtin_amdgcn_s_setprio(0); } while (0)
#define PG8_WAIT_V(n) asm volatile("s_waitcnt vmcnt(" #n ")" ::: "memory")
#define PG8_WAIT_L(n) asm volatile("s_waitcnt lgkmcnt(" #n ")" ::: "memory")
#define PG8_BAR __builtin_amdgcn_s_barrier()
#define PG8_SCHED __builtin_amdgcn_sched_barrier(0)
    Unit cur, nxt; int ui = 0;
    if (!S.next(0, cur)) return;
    f32x4 acc[2][2][4][2];
#pragma unroll
    for (int a = 0; a < 2; ++a)
#pragma unroll
        for (int b = 0; b < 2; ++b)
#pragma unroll
            for (int m = 0; m < 4; ++m)
#pragma unroll
                for (int n = 0; n < 2; ++n) acc[a][b][m][n] = (f32x4){0.f, 0.f, 0.f, 0.f};
    bf16x8 At[4][2], B0[2][2], B1[2][2];
    const char* cA = (const char*)g.A + (size_t)cur.pm * tstep; const char* cB = (const char*)g.Bt + (size_t)cur.pn * tstep;
    S.a_ready(cur);
    if constexpr (SP2) {
        PG8_STAGE(PG8_SB(0, 0), cB, voffB); PG8_STAGE(PG8_SB(0, 1), cB + hstep, voffB); PG8_STAGE(PG8_SA(0, 0), cA, voffA); PG8_STAGE(PG8_SA(0, 1), cA + hstep, voffA);
        if (wr == 1) PG8_BAR;
        PG8_WAIT_V(2); PG8_BAR;
        PG8_STAGE(PG8_SB(1, 0), cB + kstep, voffB); PG8_STAGE(PG8_SA(1, 0), cA + kstep, voffA); PG8_STAGE(PG8_SB(1, 1), cB + hstep + kstep, voffB);
        PG8_WAIT_V(6); PG8_BAR;
    } else {
        PG8_STAGE(PG8_SB(0, 0), cB, voffB); PG8_STAGE(PG8_SA(0, 0), cA, voffA); PG8_STAGE(PG8_SB(0, 1), cB + hstep, voffB); PG8_STAGE(PG8_SA(0, 1), cA + hstep, voffA);
        if (wr == 1) PG8_BAR;
        PG8_WAIT_V(4); PG8_BAR;
        PG8_STAGE(PG8_SB(1, 0), cB + kstep, voffB); PG8_STAGE(PG8_SA(1, 0), cA + kstep, voffA); PG8_STAGE(PG8_SB(1, 1), cB + hstep + kstep, voffB);
        PG8_WAIT_V(6); PG8_BAR;
    }
    for (;;) {
        const bool has_next = S.next(ui + 1, nxt);
        const char* nA = has_next ? (const char*)g.A + (size_t)nxt.pm * tstep : cA; const char* nB = has_next ? (const char*)g.Bt + (size_t)nxt.pn * tstep : cB;
        for (int t = 0; t < nt; t += 2) {
            const bool last = (t == nt - 2);
            const char* a1 = cA + (size_t)(t + 1) * kstep;
            const char* a2 = last ? nA : cA + (size_t)(t + 2) * kstep; const char* b2 = last ? nB : cB + (size_t)(t + 2) * kstep;
            const char* a3 = a2 + kstep; const char* b3 = b2 + kstep;
            if (last && has_next) S.a_ready(nxt);
            if constexpr (SP2) {
            PG8_LDB(B0, 0, 0); PG8_LDB(B1, 0, 1); PG8_SCHED; PG8_LDA(At, 0, 0); PG8_STAGE(PG8_SA(1, 1), a1 + hstep, voffA);
            PG8_WAIT_V(8); PG8_WAIT_L(0); PG8_BAR; PG8_MMA(0, 0, At, B0); PG8_MMA(0, 1, At, B1); PG8_BAR; PG8_SCHED;
            PG8_LDA(At, 0, 1); PG8_STAGE(PG8_SB(0, 0), b2, voffB); PG8_STAGE(PG8_SB(0, 1), b2 + hstep, voffB); PG8_STAGE(PG8_SA(0, 0), a2, voffA);
            PG8_WAIT_V(8); PG8_WAIT_L(0); PG8_BAR; PG8_MMA(1, 0, At, B0); PG8_MMA(1, 1, At, B1); PG8_BAR; PG8_SCHED;
            PG8_LDB(B0, 1, 0); PG8_LDB(B1, 1, 1); PG8_SCHED; PG8_LDA(At, 1, 0); PG8_STAGE(PG8_SA(0, 1), a2 + hstep, voffA);
            PG8_WAIT_V(8); PG8_WAIT_L(0); PG8_BAR; PG8_MMA(0, 0, At, B0); PG8_MMA(0, 1, At, B1); PG8_BAR; PG8_SCHED;
            PG8_LDA(At, 1, 1); PG8_STAGE(PG8_SB(1, 0), b3, voffB); PG8_STAGE(PG8_SB(1, 1), b3 + hstep, voffB); PG8_STAGE(PG8_SA(1, 0), a3, voffA);
            PG8_WAIT_V(8); PG8_WAIT_L(0); PG8_BAR; PG8_MMA(1, 0, At, B0); PG8_MMA(1, 1, At, B1); PG8_BAR; PG8_SCHED;
            } else {
            PG8_LDB(B0, 0, 0); PG8_SCHED; PG8_LDA(At, 0, 0); PG8_STAGE(PG8_SA(1, 1), a1 + hstep, voffA);
            PG8_WAIT_L(8); PG8_BAR; PG8_WAIT_L(0); PG8_MMA(0, 0, At, B0); PG8_BAR; PG8_SCHED;
            PG8_LDB(B1, 0, 1); PG8_STAGE(PG8_SB(0, 0), b2, voffB);
            PG8_BAR; PG8_WAIT_L(0); PG8_MMA(0, 1, At, B1); PG8_BAR;
            PG8_LDA(At, 0, 1); PG8_STAGE(PG8_SA(0, 0), a2, voffA);
            PG8_BAR; PG8_WAIT_L(0); PG8_MMA(1, 0, At, B0); PG8_BAR; PG8_SCHED;
            PG8_STAGE(PG8_SB(0, 1), b2 + hstep, voffB);
            PG8_WAIT_V(6); PG8_BAR; PG8_MMA(1, 1, At, B1); PG8_BAR;
            PG8_LDB(B0, 1, 0); PG8_SCHED; PG8_LDA(At, 1, 0); PG8_STAGE(PG8_SA(0, 1), a2 + hstep, voffA);
            PG8_WAIT_L(8); PG8_BAR; PG8_WAIT_L(0); PG8_MMA(0, 0, At, B0); PG8_BAR; PG8_SCHED;
            PG8_LDB(B1, 1, 1); PG8_STAGE(PG8_SB(1, 0), b3, voffB);
            PG8_BAR; PG8_WAIT_L(0); PG8_MMA(0, 1, At, B1); PG8_BAR;
            PG8_LDA(At, 1, 1); PG8_STAGE(PG8_SA(1, 0), a3, voffA);
            PG8_BAR; PG8_WAIT_L(0); PG8_MMA(1, 0, At, B0); PG8_BAR; PG8_SCHED;
            PG8_STAGE(PG8_SB(1, 1), b3 + hstep, voffB);
            PG8_WAIT_V(6); PG8_BAR; PG8_MMA(1, 1, At, B1); PG8_BAR;
            }
        }
        if constexpr (ALIGN_EPI) { if (wr == 0) PG8_BAR; }
        if constexpr (!Epi::AFTER_DRAIN) { E(acc, cur, wr, wc, fr, fq, lds + STAGE_BYTES + wid * EPI_WAVE_BYTES); S.done(cur); }
        if (!has_next) break;
#pragma unroll
        for (int a = 0; a < 2; ++a)
#pragma unroll
            for (int b = 0; b < 2; ++b)
#pragma unroll
                for (int m = 0; m < 4; ++m)
#pragma unroll
                    for (int n = 0; n < 2; ++n) acc[a][b][m][n] = (f32x4){0.f, 0.f, 0.f, 0.f};
        cur = nxt; cA = nA; cB = nB; ++ui;
        if constexpr (ALIGN_EPI) { if (wr == 1) PG8_BAR; }
    }
    PG8_WAIT_V(0);
    if constexpr (!ALIGN_EPI) { if (wr == 0) PG8_BAR; }
    PG8_BAR;
#undef PG8_SA
#undef PG8_SB
#undef PG8_STAGE
#undef PG8_LDA
#undef PG8_LDB
#undef PG8_MMA
#undef PG8_WAIT_V
#undef PG8_WAIT_L
#undef PG8_BAR
#undef PG8_SCHED
}
}

constexpr int NWAVES = 8, NTHREADS = NWAVES * 64;
constexpr int RING_BYTES = 131072, LDS_BYTES = RING_BYTES + 8 * pg8::EPI_WAVE_BYTES;

__device__ __forceinline__ void transpose_item(const float* W, int N, bf16_t* WT, int ldt, int k0, int n0, int drow0, LAS float* scr, int lane) {
#pragma unroll 8
    for (int i = 0; i < 32; ++i) { const int kk = 2 * i + (lane >> 5); scr[kk * 33 + (lane & 31)] = W[(size_t)(k0 + kk) * N + n0 + (lane & 31)]; }
    asm volatile("s_waitcnt lgkmcnt(0)" ::: "memory");
    const int c = lane & 7;
#pragma unroll
    for (int j = 0; j < 4; ++j) { const int n = (lane >> 3) + 8 * j; const LAS float* s = scr + (8 * c) * 33 + n;
        u32x4 o; o.x = pk_bf16(s[0 * 33], s[1 * 33]); o.y = pk_bf16(s[2 * 33], s[3 * 33]); o.z = pk_bf16(s[4 * 33], s[5 * 33]); o.w = pk_bf16(s[6 * 33], s[7 * 33]);
        *(u32x4*)(WT + (size_t)(drow0 + n) * ldt + k0 + 8 * c) = o; }
    asm volatile("s_waitcnt lgkmcnt(0)" ::: "memory");
}

struct Args { const float* in[17]; float* out; unsigned char* ws; int ph_lo, ph_hi; };

__device__ __forceinline__ void p0_weights(const Args& a, LAS unsigned char* lds, int gw, int NGW, int wave, int lane, int gtid, int NGT) {
    LAS float* scr = (LAS float*)(lds + wave * 16384);
    unsigned char* ws = a.ws;
    constexpr int I_G = (DM / 64) * (DFF / 32);
    constexpr int I_D = (DFF / 64) * (DM / 32);
    constexpr int I_IN = (DM / 64) * (DIN / 32);
    constexpr int I_OUT = (DM / 64) * (DM / 32);
    constexpr int NITEMS = 2 * (2 * I_G + I_D) + I_IN + I_OUT;
    for (int it = gw; it < NITEMS; it += NGW) {
        int r = it;
        bool done = false;
#pragma unroll
        for (int f = 0; f < 2; ++f) {
            if (done) break;
            const float* Wg = a.in[f ? 13 : 2]; const float* Wu = a.in[f ? 14 : 3]; const float* Wd = a.in[f ? 15 : 4];
            bf16_t* WGU = (bf16_t*)(ws + (f ? WS_WGU2 : WS_WGU1)); bf16_t* WD = (bf16_t*)(ws + (f ? WS_WD2 : WS_WD1));
            if (r < 2 * I_G) { const int up = r >= I_G; const int q = up ? r - I_G : r; const int nblk = DFF / 32, kb = q / nblk, nb = q % nblk, n0 = nb * 32;
                transpose_item(up ? Wu : Wg, DFF, WGU, DM, kb * 64, n0, 256 * (n0 >> 7) + (n0 & 127) + (up ? 128 : 0), scr, lane); done = true; break; }
            r -= 2 * I_G;
            if (r < I_D) { const int nblk = DM / 32, kb = r / nblk, nb = r % nblk; transpose_item(Wd, DM, WD, DFFP, kb * 64, nb * 32, nb * 32, scr, lane); done = true; break; }
            r -= I_D;
        }
        if (done) continue;
        if (r < I_IN) { const int nblk = DIN / 32, kb = r / nblk, nb = r % nblk; transpose_item(a.in[7], DIN, (bf16_t*)(ws + WS_WIN), DM, kb * 64, nb * 32, nb * 32, scr, lane); continue; }
        r -= I_IN;
        { const int nblk = DM / 32, kb = r / nblk, nb = r % nblk; transpose_item(a.in[10], DM, (bf16_t*)(ws + WS_WOUT), DM, kb * 64, nb * 32, nb * 32, scr, lane); }
    }
    for (int f = 0; f < 2; ++f) {
        u32x4* WGU = (u32x4*)(ws + (f ? WS_WGU2 : WS_WGU1)); u32x4* WD = (u32x4*)(ws + (f ? WS_WD2 : WS_WD1));
        for (int i = gtid; i < 128 * 128; i += NGT) { const int pr = i >> 7, c = i & 127; const int row = 256 * 21 + (pr < 64 ? 64 + pr : 128 + pr); WGU[(size_t)row * (DM / 8) + c] = (u32x4){0u, 0u, 0u, 0u}; }
        for (int i = gtid; i < 1024 * 8; i += NGT) { const int row = i >> 3, c = i & 7; WD[(size_t)row * (DFFP / 8) + (DFF / 8) + c] = (u32x4){0u, 0u, 0u, 0u}; }
    }
    { bf16_t* wlt = (bf16_t*)(ws + WS_WLT); const float* wl = a.in[8];
      for (int i = gtid; i < 4 * 64 * 64; i += NGT) { const int g = i >> 12, e = (i >> 6) & 63, c = i & 63; wlt[i] = (bf16_t)(pk_bf16(wl[g * 4096 + c * 64 + e], 0.f) & 0xffffu); } }
}

template <bool HAS_Y, bool WRITE_X, bool WRITE_H>
__device__ __forceinline__ void norm_pass(const float* xin, const bf16_t* y, const float* gpost, float coef, float* xout, const float* gnext, bf16_t* hout, int gw, int NGW, int lane) {
    f32x4 gp[4], gn[4];
#pragma unroll
    for (int j = 0; j < 4; ++j) { gp[j] = HAS_Y ? *(const f32x4*)(gpost + 4 * lane + 256 * j) : (f32x4){0.f, 0.f, 0.f, 0.f}; gn[j] = WRITE_H ? *(const f32x4*)(gnext + 4 * lane + 256 * j) : (f32x4){0.f, 0.f, 0.f, 0.f}; }
    f32x4 nv[4]; u32x2 nyr[4];
    if (gw < MROWS) {
        const f32x4* xr = (const f32x4*)(xin + (size_t)gw * DM) + lane;
#pragma unroll
        for (int j = 0; j < 4; ++j) nv[j] = xr[64 * j];
        if constexpr (HAS_Y) { const u32x2* yr = (const u32x2*)(y + (size_t)gw * DM) + lane;
#pragma unroll
            for (int j = 0; j < 4; ++j) nyr[j] = yr[64 * j]; }
    }
    for (int row = gw; row < MROWS; row += NGW) {
        f32x4 v[4]; u32x2 yraw[4];
#pragma unroll
        for (int j = 0; j < 4; ++j) { v[j] = nv[j]; if constexpr (HAS_Y) yraw[j] = nyr[j]; }
        const int nrow = row + NGW;
        if (nrow < MROWS) {
            const f32x4* xr = (const f32x4*)(xin + (size_t)nrow * DM) + lane;
#pragma unroll
            for (int j = 0; j < 4; ++j) nv[j] = xr[64 * j];
            if constexpr (HAS_Y) { const u32x2* yr = (const u32x2*)(y + (size_t)nrow * DM) + lane;
#pragma unroll
                for (int j = 0; j < 4; ++j) nyr[j] = yr[64 * j]; }
        }
        if constexpr (HAS_Y) {
            f32x4 yv[4]; float ss = 0.f;
#pragma unroll
            for (int j = 0; j < 4; ++j) { const u32x2 u = yraw[j]; yv[j] = (f32x4){bf_lo(u.x), bf_hi(u.x), bf_lo(u.y), bf_hi(u.y)}; ss += (yv[j].x * yv[j].x + yv[j].y * yv[j].y) + (yv[j].z * yv[j].z + yv[j].w * yv[j].w); }
            const float r = coef * __builtin_amdgcn_rsqf(wave_sum(ss) * (1.0f / DM) + RMS_EPS);
#pragma unroll
            for (int j = 0; j < 4; ++j) v[j] = v[j] + yv[j] * gp[j] * r;
        }
        if constexpr (WRITE_X) {
            f32x4* xo = (f32x4*)(xout + (size_t)row * DM) + lane;
#pragma unroll
            for (int j = 0; j < 4; ++j) xo[64 * j] = v[j];
        }
        if constexpr (WRITE_H) {
            float ss = 0.f;
#pragma unroll
            for (int j = 0; j < 4; ++j) ss += (v[j].x * v[j].x + v[j].y * v[j].y) + (v[j].z * v[j].z + v[j].w * v[j].w);
            const float r = __builtin_amdgcn_rsqf(wave_sum(ss) * (1.0f / DM) + RMS_EPS);
            u32x2* ho = (u32x2*)(hout + (size_t)row * DM) + lane;
#pragma unroll
            for (int j = 0; j < 4; ++j) { const f32x4 h = v[j] * gn[j] * r; ho[64 * j] = (u32x2){pk_bf16(h.x, h.y), pk_bf16(h.z, h.w)}; }
        }
    }
}

template <int GI>
__device__ __forceinline__ void pool_task(const bf16_t* z, const bf16_t* wlt, const float* pscale, bf16_t* mix, int strip, int lane) {
    constexpr int HW = 1 << GI, WN = 2 * HW;
    const int fr = lane & 15, fq = lane >> 4;
    const int row = strip * 16 + fr, t = row & (SEQ - 1), bbase = row - t;
    const int lo = max(t - HW, 0), hi = min(t + HW, SEQ);
    const float inv = 1.0f / (float)(hi - lo);
    bf16x8 yb[2];
#pragma unroll
    for (int kk = 0; kk < 2; ++kk) {
        const int c0 = GI * 64 + 8 * fq + 32 * kk;
        u32x4 ld[WN];
#pragma unroll
        for (int i = 0; i < WN; ++i) { const int tt = min(max(t - HW + i, 0), SEQ - 1); ld[i] = *(const u32x4*)(z + (size_t)(bbase + tt) * DIN + c0); }
        float s[8];
#pragma unroll
        for (int e = 0; e < 8; ++e) s[e] = 0.f;
#pragma unroll
        for (int i = 0; i < WN; ++i) { const int tt = t - HW + i; const float mk = (tt >= 0 && tt < SEQ) ? 1.0f : 0.0f; const u32x4 u = ld[i];
            s[0] += mk * bf_lo(u.x); s[1] += mk * bf_hi(u.x); s[2] += mk * bf_lo(u.y); s[3] += mk * bf_hi(u.y); s[4] += mk * bf_lo(u.z); s[5] += mk * bf_hi(u.z); s[6] += mk * bf_lo(u.w); s[7] += mk * bf_hi(u.w); }
        const u32x4 u = ld[HW];
        u32x4 p; p.x = pk_bf16(s[0] * inv - bf_lo(u.x), s[1] * inv - bf_hi(u.x)); p.y = pk_bf16(s[2] * inv - bf_lo(u.y), s[3] * inv - bf_hi(u.y));
        p.z = pk_bf16(s[4] * inv - bf_lo(u.z), s[5] * inv - bf_hi(u.z)); p.w = pk_bf16(s[6] * inv - bf_lo(u.w), s[7] * inv - bf_hi(u.w));
        yb[kk] = __builtin_bit_cast(bf16x8, p);
    }
#pragma unroll
    for (int eb = 0; eb < 4; ++eb) {
        f32x4 acc = {0.f, 0.f, 0.f, 0.f};
#pragma unroll
        for (int kk = 0; kk < 2; ++kk) { const bf16x8 wa = *(const bf16x8*)(wlt + (size_t)GI * 4096 + (16 * eb + fr) * 64 + 8 * fq + 32 * kk);
            acc = __builtin_amdgcn_mfma_f32_16x16x32_bf16(wa, yb[kk], acc, 0, 0, 0); }
        const f32x4 sc = *(const f32x4*)(pscale + GI * 64 + 16 * eb + 4 * fq);
        acc = acc * sc;
        *(u32x2*)(mix + (size_t)row * DM + GI * 64 + 16 * eb + 4 * fq) = (u32x2){pk_bf16(acc.x, acc.y), pk_bf16(acc.z, acc.w)};
    }
}
__device__ __forceinline__ void pool_phase(const bf16_t* z, const bf16_t* wlt, const float* pscale, bf16_t* mix, int gw, int NGW, int lane) {
    for (int strip = gw; strip < MROWS / 16; strip += NGW) {
        pool_task<0>(z, wlt, pscale, mix, strip, lane); pool_task<1>(z, wlt, pscale, mix, strip, lane);
        pool_task<2>(z, wlt, pscale, mix, strip, lane); pool_task<3>(z, wlt, pscale, mix, strip, lane);
    }
}

constexpr int AT_PITCH = 144, AT_ROWS = 272, AT_KOFF = 0, AT_VOFF = AT_ROWS * AT_PITCH;
struct AtUnit { int h, dsh, L, n0; size_t rowbase; };
__device__ __forceinline__ AtUnit at_decode(int unit) {
    AtUnit u; const int bh = unit >> 6, j = unit & 63, b = bh / NHEAD; u.h = bh - b * NHEAD; const int g = u.h >> 2;
    u.dsh = 2 * g; u.L = SEQ >> u.dsh;
    const int r = j >> (6 - u.dsh), c = j & ((64 >> u.dsh) - 1); u.n0 = c * 128; u.rowbase = (size_t)b * SEQ + r; return u;
}
__device__ __forceinline__ void at_fetch(const bf16_t* z, const AtUnit& u, int tid, int w, int fr, int fq, u32x4 (&kv)[4], u32x4 (&vv)[4], bf16x8 (&qf)[2]) {
#pragma unroll
    for (int i = 0; i < 4; ++i) { const int id = tid + NTHREADS * i, row = id >> 3, ch = id & 7, n = u.n0 - 64 + row;
        kv[i] = (u32x4){0u, 0u, 0u, 0u}; vv[i] = kv[i];
        if (n >= 0 && n < u.L) { const bf16_t* src = z + (u.rowbase + ((size_t)n << u.dsh)) * DIN + u.h * 64 + ch * 8; kv[i] = *(const u32x4*)(src + KOFF_Z); vv[i] = *(const u32x4*)(src + VOFF_Z); } }
    const size_t qrow = u.rowbase + ((size_t)(u.n0 + 16 * w + fr) << u.dsh);
#pragma unroll
    for (int kk = 0; kk < 2; ++kk) qf[kk] = *(const bf16x8*)(z + qrow * DIN + QOFF + u.h * 64 + 8 * fq + 32 * kk);
}
__device__ __forceinline__ void attn_phase(LAS unsigned char* lds, const bf16_t* z, bf16_t* mix, float* lse, int G, int bid, int tid) {
    const int lane = tid & 63, w = __builtin_amdgcn_readfirstlane(tid >> 6), fr = lane & 15, fq = lane >> 4;
    constexpr int NUNITS = BATCH * NHEAD * 64;
    for (int i = tid; i < 16 * AT_PITCH / 4; i += NTHREADS) { ((LAS unsigned*)(lds + AT_VOFF + 256 * AT_PITCH))[i] = 0u; ((LAS unsigned*)(lds + AT_KOFF + 256 * AT_PITCH))[i] = 0u; }
    u32x4 kv[4], vv[4]; bf16x8 qn[2];
    if (bid < NUNITS) { const AtUnit u0 = at_decode(bid); at_fetch(z, u0, tid, w, fr, fq, kv, vv, qn); }
    for (int unit = bid; unit < NUNITS; unit += G) {
        const AtUnit u = at_decode(unit);
        const int h = u.h, dsh = u.dsh, L = u.L, n0 = u.n0;
        __syncthreads();
#pragma unroll
        for (int i = 0; i < 4; ++i) { const int id = tid + NTHREADS * i, row = id >> 3, ch = id & 7;
            *(LAS u32x4*)(lds + AT_KOFF + row * AT_PITCH + ch * 16) = kv[i]; *(LAS u32x4*)(lds + AT_VOFF + row * AT_PITCH + ch * 16) = vv[i]; }
        bf16x8 qf[2]; qf[0] = qn[0]; qf[1] = qn[1];
        const size_t qrow = u.rowbase + ((size_t)(n0 + 16 * w + fr) << dsh);
        __syncthreads();
        if (unit + G < NUNITS) { const AtUnit un = at_decode(unit + G); at_fetch(z, un, tid, w, fr, fq, kv, vv, qn); }
        f32x4 s[9];
#pragma unroll
        for (int kt = 0; kt < 9; ++kt) {
            const LAS unsigned char* kp = lds + AT_KOFF + (16 * w + 16 * kt + fr) * AT_PITCH + 16 * fq;
            const bf16x8 a0 = *(const LAS bf16x8*)kp, a1 = *(const LAS bf16x8*)(kp + 64);
            f32x4 acc = {0.f, 0.f, 0.f, 0.f};
            acc = __builtin_amdgcn_mfma_f32_16x16x32_bf16(a0, qf[0], acc, 0, 0, 0);
            acc = __builtin_amdgcn_mfma_f32_16x16x32_bf16(a1, qf[1], acc, 0, 0, 0);
            s[kt] = acc;
        }
        const float c1 = 0.125f * 1.44269504089f;
        const float c2 = exp2f(-8.0f * (float)(h + 1) / 12.0f) * (float)(1 << dsh) * 1.44269504089f;
        float mx = -INFINITY;
#pragma unroll
        for (int kt = 0; kt < 9; ++kt)
#pragma unroll
            for (int e = 0; e < 4; ++e) {
                const int rel = 16 * kt + 4 * fq + e - 64 - fr;
                const int nk = n0 + 16 * w + fr + rel;
                const bool ok = (rel >= -64) && (rel <= 64) && (nk >= 0) && (nk < L);
                const float v = ok ? s[kt][e] * c1 - c2 * (float)(rel < 0 ? -rel : rel) : -INFINITY;
                s[kt][e] = v; mx = fmaxf(mx, v);
            }
        mx = fmaxf(mx, __shfl_xor(mx, 16)); mx = fmaxf(mx, __shfl_xor(mx, 32));
        float sum = 0.f;
#pragma unroll
        for (int kt = 0; kt < 9; ++kt)
#pragma unroll
            for (int e = 0; e < 4; ++e) { const float p = __builtin_amdgcn_exp2f(s[kt][e] - mx); s[kt][e] = p; sum += p; }
        sum += __shfl_xor(sum, 16); sum += __shfl_xor(sum, 32);
        f32x4 o[4];
#pragma unroll
        for (int db = 0; db < 4; ++db) o[db] = (f32x4){0.f, 0.f, 0.f, 0.f};
        const int tq = (lane & 15) >> 2, tp = lane & 3;
#pragma unroll
        for (int cc = 0; cc < 5; ++cc) {
            u32x4 pp; pp.x = pk_bf16(s[2 * cc][0], s[2 * cc][1]); pp.y = pk_bf16(s[2 * cc][2], s[2 * cc][3]);
            if (cc < 4) { pp.z = pk_bf16(s[2 * cc + 1][0], s[2 * cc + 1][1]); pp.w = pk_bf16(s[2 * cc + 1][2], s[2 * cc + 1][3]); } else { pp.z = 0u; pp.w = 0u; }
            const bf16x8 pb = __builtin_bit_cast(bf16x8, pp);
            const LAS unsigned char* vp = lds + AT_VOFF + (16 * w + 32 * cc + 4 * fq + tq) * AT_PITCH + 8 * tp;
#pragma unroll
            for (int db = 0; db < 4; ++db) {
                const s16x4 v0 = __builtin_amdgcn_ds_read_tr16_b64_v4i16((LAS s16x4*)(vp + 32 * db));
                const s16x4 v1 = __builtin_amdgcn_ds_read_tr16_b64_v4i16((LAS s16x4*)(vp + 16 * AT_PITCH + 32 * db));
                const bf16x8 va = {v0[0], v0[1], v0[2], v0[3], v1[0], v1[1], v1[2], v1[3]};
                o[db] = __builtin_amdgcn_mfma_f32_16x16x32_bf16(va, pb, o[db], 0, 0, 0);
            }
        }
        const float inv = 1.0f / sum;
        bf16_t* op = mix + qrow * DM + 256 + h * 64 + 4 * fq;
#pragma unroll
        for (int db = 0; db < 4; ++db) { const f32x4 v = o[db] * inv; *(u32x2*)(op + 16 * db) = (u32x2){pk_bf16(v.x, v.y), pk_bf16(v.z, v.w)}; }
        if (fq == 0) lse[qrow * NHEAD + h] = (mx + __builtin_amdgcn_logf(sum)) * 0.69314718056f;
    }
    __syncthreads();
}

__device__ __forceinline__ void alpha_pass(bf16_t* mix, const float* lse, int gw, int NGW, int lane) {
    const int hg = lane >> 4;
    for (int row = gw; row < MROWS; row += NGW) {
        const float* lr = lse + (size_t)row * NHEAD;
        const float l0 = lr[hg], l1 = lr[4 + hg], l2 = lr[8 + hg];
        const float m = fmaxf(l0, fmaxf(l1, l2));
        const float e0 = __expf(l0 - m), e1 = __expf(l1 - m), e2 = __expf(l2 - m);
        const float inv = 1.0f / (e0 + e1 + e2);
        const float al[3] = {e0 * inv, e1 * inv, e2 * inv};
        u32x2* p = (u32x2*)(mix + (size_t)row * DM + 256) + lane;
#pragma unroll
        for (int i = 0; i < 3; ++i) { const u32x2 u = p[64 * i]; const float a = al[i];
            p[64 * i] = (u32x2){pk_bf16(bf_lo(u.x) * a, bf_hi(u.x) * a), pk_bf16(bf_lo(u.y) * a, bf_hi(u.y) * a)}; }
    }
}

__global__ void __launch_bounds__(NTHREADS, 2) fwd_kernel(Args args) {
    extern __shared__ __attribute__((aligned(16))) unsigned char lds_raw[];
    LAS unsigned char* lds = (LAS unsigned char*)lds_raw;
    cg::grid_group grid = cg::this_grid();
    const int tid = threadIdx.x, lane = tid & 63, wave = __builtin_amdgcn_readfirstlane(tid >> 6);
    const int G = gridDim.x, bid = blockIdx.x;
    const int gw = bid * NWAVES + wave, NGW = G * NWAVES, gtid = bid * NTHREADS + tid, NGT = G * NTHREADS;
    unsigned char* ws = args.ws;
    bf16_t* WGU1 = (bf16_t*)(ws + WS_WGU1); bf16_t* WD1 = (bf16_t*)(ws + WS_WD1); bf16_t* WIN = (bf16_t*)(ws + WS_WIN); bf16_t* WOUT = (bf16_t*)(ws + WS_WOUT);
    bf16_t* WGU2 = (bf16_t*)(ws + WS_WGU2); bf16_t* WD2 = (bf16_t*)(ws + WS_WD2); bf16_t* WLT = (bf16_t*)(ws + WS_WLT);
    float* LSE = (float*)(ws + WS_LSE);
    bf16_t* HB = (bf16_t*)(ws + WS_H); bf16_t* YB = (bf16_t*)(ws + WS_Y); bf16_t* AB = (bf16_t*)(ws + WS_A); bf16_t* ZB = AB;
    const float* x = args.in[0]; float* out = args.out;
    const int lo = args.ph_lo, hi = args.ph_hi;
#define IN(k) (lo <= (k) && (k) < hi)
#define SEAM(k) do { if (IN(k) && IN((k) + 1)) grid.sync(); } while (0)

    if (IN(0)) { p0_weights(args, lds, gw, NGW, wave, lane, gtid, NGT);
        norm_pass<false, false, true>(x, nullptr, nullptr, 0.f, nullptr, args.in[1], HB, gw, NGW, lane); }
    SEAM(0);
    if (IN(1)) { pg8::Gemm g{HB, WGU1, MROWS, NGU, DM}; pg8::StaticOrder S; S.init(MROWS, NGU, G, bid); pg8::EpiSwiGLU E{AB, DFFP};
        pg8::gemm_phase<pg8::EpiSwiGLU, pg8::StaticOrder, true, true>(lds, g, S, E); }
    SEAM(1);
    if (IN(2)) { pg8::Gemm g{AB, WD1, MROWS, DM, DFFP}; pg8::StaticOrder S; S.init(MROWS, DM, G, bid); pg8::EpiBf16 E{YB, DM};
        pg8::gemm_phase<pg8::EpiBf16, pg8::StaticOrder, true, true>(lds, g, S, E); }
    SEAM(2);
    if (IN(3)) norm_pass<true, true, true>(x, YB, args.in[5], 0.5f, out, args.in[6], HB, gw, NGW, lane);
    SEAM(3);
    if (IN(4)) { pg8::Gemm g{HB, WIN, MROWS, DIN, DM}; pg8::StaticOrder S; S.init(MROWS, DIN, G, bid); pg8::EpiBf16 E{ZB, DIN};
        pg8::gemm_phase<pg8::EpiBf16, pg8::StaticOrder, true, true>(lds, g, S, E); }
    SEAM(4);
    if (IN(5)) { pool_phase(ZB, WLT, args.in[9], HB, gw, NGW, lane); attn_phase(lds, ZB, HB, LSE, G, bid, tid); }
    SEAM(5);
    if (IN(6)) alpha_pass(HB, LSE, gw, NGW, lane);
    SEAM(6);
    if (IN(7)) { pg8::Gemm g{HB, WOUT, MROWS, DM, DM}; pg8::StaticOrder S; S.init(MROWS, DM, G, bid); pg8::EpiBf16 E{YB, DM};
        pg8::gemm_phase<pg8::EpiBf16, pg8::StaticOrder, true, true>(lds, g, S, E); }
    SEAM(7);
    if (IN(8)) norm_pass<true, true, true>(out, YB, args.in[11], 1.0f, out, args.in[12], HB, gw, NGW, lane);
    SEAM(8);
    if (IN(9)) { pg8::Gemm g{HB, WGU2, MROWS, NGU, DM}; pg8::StaticOrder S; S.init(MROWS, NGU, G, bid); pg8::EpiSwiGLU E{AB, DFFP};
        pg8::gemm_phase<pg8::EpiSwiGLU, pg8::StaticOrder, true, true>(lds, g, S, E); }
    SEAM(9);
    if (IN(10)) { pg8::Gemm g{AB, WD2, MROWS, DM, DFFP}; pg8::StaticOrder S; S.init(MROWS, DM, G, bid); pg8::EpiBf16 E{YB, DM};
        pg8::gemm_phase<pg8::EpiBf16, pg8::StaticOrder, true, true>(lds, g, S, E); }
    SEAM(10);
    if (IN(11)) norm_pass<true, true, false>(out, YB, args.in[16], 0.5f, out, nullptr, nullptr, gw, NGW, lane);
#undef IN
#undef SEAM
}

constexpr int NPHASES = 12;
#ifndef MK_PER_PHASE
#define MK_PER_PHASE 0
#endif

extern "C" void kernel_launch(void* const* d_in, const int* in_sizes, int n_in, void* d_out, int out_size, void* d_ws, size_t ws_size, hipStream_t stream) {
    static int grid = 0;
    if (grid == 0) {
        if (n_in != 17 || out_size != MROWS * DM || ws_size < WS_END) { fprintf(stderr, "kernel_launch: unexpected shapes (n_in %d out %d ws %zu)\n", n_in, out_size, ws_size); grid = -1; return; }
        int dev = 0, cus = 0, per_cu = 0;
        hipGetDevice(&dev);
        hipDeviceGetAttribute(&cus, hipDeviceAttributeMultiprocessorCount, dev);
        if (hipFuncSetAttribute((const void*)fwd_kernel, hipFuncAttributeMaxDynamicSharedMemorySize, LDS_BYTES) != hipSuccess) { fprintf(stderr, "kernel_launch: hipFuncSetAttribute failed\n"); grid = -1; return; }
        if (hipOccupancyMaxActiveBlocksPerMultiprocessor(&per_cu, (const void*)fwd_kernel, NTHREADS, LDS_BYTES) != hipSuccess || per_cu < 1) { fprintf(stderr, "kernel_launch: occupancy query gave %d\n", per_cu); per_cu = 1; }
        (void)hipGetLastError();
        grid = cus * per_cu;
        fprintf(stderr, "kernel_launch: cus %d per_cu %d grid %d\n", cus, per_cu, grid);
    }
    if (grid < 0) return;
    Args a{};
    for (int i = 0; i < 17; ++i) a.in[i] = (const float*)d_in[i];
    a.out = (float*)d_out; a.ws = (unsigned char*)d_ws;
#if MK_PER_PHASE
    for (int p = 0; p < NPHASES; ++p) { a.ph_lo = p; a.ph_hi = p + 1; hipLaunchKernelGGL(fwd_kernel, dim3(grid), dim3(NTHREADS), LDS_BYTES, stream, a); }
#else
    a.ph_lo = 0; a.ph_hi = NPHASES;
    void* kargs[] = {&a};
    hipError_t e = hipLaunchCooperativeKernel((const void*)fwd_kernel, dim3(grid), dim3(NTHREADS), kargs, LDS_BYTES, stream);
    if (e != hipSuccess) fprintf(stderr, "kernel_launch: cooperative launch failed: %s (grid %d)\n", hipGetErrorString(e), grid);
#endif
}
```

```cpp
#include <hip/hip_runtime.h>
#include <hip/hip_cooperative_groups.h>
#include <cstdio>
#include <cstdint>
namespace cg = cooperative_groups;

#define LAS __attribute__((address_space(3)))
typedef unsigned short bf16_t;
typedef short bf16x8 __attribute__((ext_vector_type(8)));
typedef short s16x4 __attribute__((ext_vector_type(4)));
typedef float f32x4 __attribute__((ext_vector_type(4)));
typedef float f32x2 __attribute__((ext_vector_type(2)));
typedef unsigned u32x4 __attribute__((ext_vector_type(4)));
typedef unsigned u32x2 __attribute__((ext_vector_type(2)));
typedef __bf16 bf16v2 __attribute__((ext_vector_type(2)));

constexpr int BATCH = 8, SEQ = 8192, DM = 1024, MROWS = BATCH * SEQ;
constexpr int DFF = 2752, DFFP = 2816;
constexpr int NGU = 2 * DFFP;
constexpr int DIN = 2560, NHEAD = 12;
constexpr int QOFF = 256, KOFF_Z = 1024, VOFF_Z = 1792;
constexpr float RMS_EPS = 1e-6f;

constexpr size_t MiB = 1u << 20;
constexpr size_t WS_WGU1 = 0, WS_WD1 = 12 * MiB, WS_WIN = 18 * MiB, WS_WOUT = 24 * MiB, WS_WGU2 = 26 * MiB, WS_WD2 = 38 * MiB, WS_WLT = 44 * MiB;
constexpr size_t WS_CTL = 48 * MiB, CTL_BYTES = 16384;
constexpr size_t WS_LSE = 45 * MiB;
constexpr size_t WS_H = 64 * MiB;
constexpr size_t WS_Y = 192 * MiB;
constexpr size_t WS_A = 320 * MiB;
constexpr size_t WS_XB = 672 * MiB;
constexpr size_t WS_END = 800 * MiB;
static_assert((size_t)NGU * DM * 2 <= 12 * MiB && (size_t)DM * DFFP * 2 <= 6 * MiB && (size_t)DIN * DM * 2 <= 6 * MiB, "weight map");

__device__ __forceinline__ unsigned pk_bf16(float lo, float hi) { f32x2 v = {lo, hi}; bf16v2 c = __builtin_convertvector(v, bf16v2); return __builtin_bit_cast(unsigned, c); }
__device__ __forceinline__ float bf_lo(unsigned u) { return __uint_as_float(u << 16); }
__device__ __forceinline__ float bf_hi(unsigned u) { return __uint_as_float(u & 0xffff0000u); }
__device__ __forceinline__ float wave_sum(float v) {
#pragma unroll
    for (int o = 1; o < 64; o <<= 1) v += __shfl_xor(v, o);
    return v;
}

namespace pg8 {
constexpr int BM = 256, BK = 64, HALF = 128, HTB = HALF * BK * 2, STAGE_BYTES = 8 * HTB, NXCD = 8, WGM = 8;
__host__ __device__ __forceinline__ int lds_byte(int r, int c) { const int st = (r >> 4) * 2 + (c >> 5), rr = r & 15, cc = c & 31, ob = rr * 64 + cc * 2; return st * 1024 + (ob ^ (((ob >> 9) & 1) << 5)); }
__host__ __device__ __forceinline__ void stage_rc(int b, int& R, int& C) { const int st = b / 1024, sb = b % 1024, swz = sb ^ (((sb >> 9) & 1) << 5); R = (st >> 1) * 16 + swz / 64; C = (st & 1) * 32 + (swz % 64) / 2; }
__host__ __device__ __forceinline__ int perm32(int rho) { const int n = rho >> 4, i = rho & 15; return 8 * (i >> 2) + 4 * n + (i & 3); }

struct Unit { int pm, pn; };
struct Gemm { const bf16_t* A; const bf16_t* Bt; int M, N, K; };

struct StaticOrder {
    int nM, nN, nwg, G, c;
    __host__ __device__ void init(int M, int N, int G_, int c_) { nM = M / BM; nN = N / BM; nwg = nM * nN; G = G_; c = c_; }
    __host__ __device__ bool next(int i, Unit& u) const {
        const long L = (long)i * G + c; if (L >= nwg) return false;
        int wgid = (int)L; { const int q = nwg / NXCD, r = nwg % NXCD, xcd = wgid % NXCD, off = wgid / NXCD; wgid = (xcd < r ? xcd * (q + 1) : r * (q + 1) + (xcd - r) * q) + off; }
        const int nig = WGM * nN, gid = wgid / nig, fm = gid * WGM, gsz = (nM - fm) < WGM ? (nM - fm) : WGM;
        u.pm = fm + ((wgid % nig) % gsz); u.pn = (wgid % nig) / gsz; return true;
    }
    __device__ __forceinline__ void a_ready(const Unit&) const {}
    __device__ __forceinline__ void done(const Unit&) const {}
};

constexpr int EPI_PITCH = 144, EPI_WAVE_BYTES = 16 * EPI_PITCH;
struct EpiBf16 {
    static constexpr bool PERM = true, AFTER_DRAIN = false;
    bf16_t* O; int ldc;
    __device__ __forceinline__ void operator()(const f32x4 (&acc)[2][2][4][2], const Unit& u, int wr, int wc, int fr, int fq, LAS unsigned char* stg) const {
        const int lane = fr + 16 * fq, r4 = lane >> 2, c4 = lane & 3;
        bf16_t* base = O + (size_t)(u.pm * BM + wr * 64 + r4) * ldc + u.pn * BM + wc * 32 + c4 * 8;
        LAS unsigned char* wp = stg + fr * EPI_PITCH + fq * 16; const LAS unsigned char* rp = stg + r4 * EPI_PITCH + c4 * 16;
#pragma unroll
        for (int ai = 0; ai < 2; ++ai)
#pragma unroll
            for (int m = 0; m < 4; ++m) {
#pragma unroll
                for (int bj = 0; bj < 2; ++bj) { const f32x4 v0 = acc[ai][bj][m][0], v1 = acc[ai][bj][m][1];
                    u32x4 w; w.x = pk_bf16(v0[0], v0[1]); w.y = pk_bf16(v0[2], v0[3]); w.z = pk_bf16(v1[0], v1[1]); w.w = pk_bf16(v1[2], v1[3]);
                    *(LAS u32x4*)(wp + bj * 64) = w; }
                bf16_t* rowp = base + (size_t)(ai * HALF + m * 16) * ldc;
#pragma unroll
                for (int bj = 0; bj < 2; ++bj) { const u32x4 v = *(const LAS u32x4*)(rp + bj * 64); *(u32x4*)(rowp + bj * HALF) = v; }
            }
    }
};
__device__ __forceinline__ unsigned silu_mul_pk(float g0, float g1, float u0, float u1) {
    const f32x2 g = {g0, g1}, u = {u0, u1}; const f32x2 t = g * -1.44269504089f;
    f32x2 e; e.x = __builtin_amdgcn_exp2f(t.x); e.y = __builtin_amdgcn_exp2f(t.y);
    const f32x2 d = e + 1.0f; f32x2 r; r.x = __builtin_amdgcn_rcpf(d.x); r.y = __builtin_amdgcn_rcpf(d.y);
    const f32x2 o = (g * u) * r; return pk_bf16(o.x, o.y); }
struct EpiSwiGLU {
    static constexpr bool PERM = true, AFTER_DRAIN = false;
    bf16_t* O; int ldc;
    __device__ __forceinline__ void operator()(const f32x4 (&acc)[2][2][4][2], const Unit& u, int wr, int wc, int fr, int fq, LAS unsigned char* stg) const {
        const int lane = fr + 16 * fq, r4 = lane >> 2, c4 = lane & 3;
        bf16_t* base = O + (size_t)(u.pm * BM + wr * 64 + r4) * ldc + u.pn * HALF + wc * 32 + c4 * 8;
        LAS unsigned char* wp = stg + fr * EPI_PITCH + fq * 16; const LAS unsigned char* rp = stg + r4 * EPI_PITCH + c4 * 16;
#pragma unroll
        for (int ai = 0; ai < 2; ++ai)
#pragma unroll
            for (int mp = 0; mp < 2; ++mp) {
#pragma unroll
                for (int mm = 0; mm < 2; ++mm) { const int m = 2 * mp + mm;
                    const f32x4 g0 = acc[ai][0][m][0], g1 = acc[ai][0][m][1], u0 = acc[ai][1][m][0], u1 = acc[ai][1][m][1];
                    u32x4 w; w.x = silu_mul_pk(g0[0], g0[1], u0[0], u0[1]); w.y = silu_mul_pk(g0[2], g0[3], u0[2], u0[3]);
                    w.z = silu_mul_pk(g1[0], g1[1], u1[0], u1[1]); w.w = silu_mul_pk(g1[2], g1[3], u1[2], u1[3]);
                    *(LAS u32x4*)(wp + mm * 64) = w; }
#pragma unroll
                for (int mm = 0; mm < 2; ++mm) { const u32x4 v = *(const LAS u32x4*)(rp + mm * 64); *(u32x4*)(base + (size_t)(ai * HALF + (2 * mp + mm) * 16) * ldc) = v; }
            }
    }
};

template <class Epi, class Sched, bool ALIGN_EPI = false, bool SP2 = false>
__device__ __forceinline__ void gemm_phase(LAS unsigned char* lds, const Gemm g, const Sched& S, const Epi& E) {
    const int tid = threadIdx.x, wid = __builtin_amdgcn_readfirstlane(tid >> 6), lane = tid & 63, wr = wid >> 2, wc = wid & 3, fr = lane & 15, fq = lane >> 4;
    const int K = g.K, nt = K / BK;
    unsigned voffA[2], voffB[2];
#pragma unroll
    for (int i = 0; i < 2; ++i) { int R, C; stage_rc(tid * 16 + i * 8192, R, C); const int Rb = Epi::PERM ? ((R & ~31) + perm32(R & 31)) : R;
        voffA[i] = (unsigned)(R * K + C) * 2u; voffB[i] = (unsigned)(Rb * K + C) * 2u; }
    const size_t kstep = (size_t)(BK * 2);
    const size_t hstep = (size_t)HALF * K * 2;
    const size_t tstep = 2 * hstep;
    const unsigned ldsw = (unsigned)wid * 1024u;
    const int aoff = lds_byte(wr * 64 + fr, fq * 8), boff = lds_byte(wc * 32 + fr, fq * 8);
#define PG8_SA(b, h) (((b) * 2 + (h)) * HTB)
#define PG8_SB(b, h) ((4 + (b) * 2 + (h)) * HTB)
#define PG8_STAGE(bufoff, gbase, voff) do { _Pragma("unroll") for (int _i = 0; _i < 2; ++_i) \
        __builtin_amdgcn_global_load_lds((const unsigned*)((const char*)(gbase) + (voff)[_i]), (LAS unsigned*)(lds + (bufoff) + ldsw + _i * 8192), 16, 0, 0); } while (0)
#define PG8_LDA(dst, b, h) do { _Pragma("unroll") for (int m = 0; m < 4; ++m) _Pragma("unroll") for (int k = 0; k < 2; ++k) dst[m][k] = *(const LAS bf16x8*)(lds + PG8_SA(b, h) + aoff + m * 2048 + k * 1024); } while (0)
#define PG8_LDB(dst, b, h) do { _Pragma("unroll") for (int n = 0; n < 2; ++n) _Pragma("unroll") for (int k = 0; k < 2; ++k) dst[n][k] = *(const LAS bf16x8*)(lds + PG8_SB(b, h) + boff + n * 2048 + k * 1024); } while (0)
#define PG8_MMA(ai, bj, At, Bt) do { __builtin_amdgcn_s_setprio(1); _Pragma("unroll") for (int m = 0; m < 4; ++m) _Pragma("unroll") for (int n = 0; n < 2; ++n) _Pragma("unroll") for (int k = 0; k < 2; ++k) \
        acc[ai][bj][m][n] = __builtin_amdgcn_mfma_f32_16x16x32_bf16(Bt[n][k], At[m][k], acc[ai][bj][m][n], 0, 0, 0); __builtin_amdgcn_s_setprio(0); } while (0)
#define PG8_WAIT_V(n) asm volatile("s_waitcnt vmcnt(" #n ")" ::: "memory")
#define PG8_WAIT_L(n) asm volatile("s_waitcnt lgkmcnt(" #n ")" ::: "memory")
#define PG8_BAR __builtin_amdgcn_s_barrier()
#define PG8_SCHED __builtin_amdgcn_sched_barrier(0)
    Unit cur, nxt; int ui = 0;
    if (!S.next(0, cur)) return;
    f32x4 acc[2][2][4][2];
#pragma unroll
    for (int a = 0; a < 2; ++a)
#pragma unroll
        for (int b = 0; b < 2; ++b)
#pragma unroll
            for (int m = 0; m < 4; ++m)
#pragma unroll
                for (int n = 0; n < 2; ++n) acc[a][b][m][n] = (f32x4){0.f, 0.f, 0.f, 0.f};
    bf16x8 At[4][2], B0[2][2], B1[2][2];
    const char* cA = (const char*)g.A + (size_t)cur.pm * tstep; const char* cB = (const char*)g.Bt + (size_t)cur.pn * tstep;
    S.a_ready(cur);
    if constexpr (SP2) {
        PG8_STAGE(PG8_SB(0, 0), cB, voffB); PG8_STAGE(PG8_SB(0, 1), cB + hstep, voffB); PG8_STAGE(PG8_SA(0, 0), cA, voffA); PG8_STAGE(PG8_SA(0, 1), cA + hstep, voffA);
        if (wr == 1) PG8_BAR;
        PG8_WAIT_V(2); PG8_BAR;
        PG8_STAGE(PG8_SB(1, 0), cB + kstep, voffB); PG8_STAGE(PG8_SA(1, 0), cA + kstep, voffA); PG8_STAGE(PG8_SB(1, 1), cB + hstep + kstep, voffB);
        PG8_WAIT_V(6); PG8_BAR;
    } else {
        PG8_STAGE(PG8_SB(0, 0), cB, voffB); PG8_STAGE(PG8_SA(0, 0), cA, voffA); PG8_STAGE(PG8_SB(0, 1), cB + hstep, voffB); PG8_STAGE(PG8_SA(0, 1), cA + hstep, voffA);
        if (wr == 1) PG8_BAR;
        PG8_WAIT_V(4); PG8_BAR;
        PG8_STAGE(PG8_SB(1, 0), cB + kstep, voffB); PG8_STAGE(PG8_SA(1, 0), cA + kstep, voffA); PG8_STAGE(PG8_SB(1, 1), cB + hstep + kstep, voffB);
        PG8_WAIT_V(6); PG8_BAR;
    }
    for (;;) {
        const bool has_next = S.next(ui + 1, nxt);
        const char* nA = has_next ? (const char*)g.A + (size_t)nxt.pm * tstep : cA; const char* nB = has_next ? (const char*)g.Bt + (size_t)nxt.pn * tstep : cB;
        for (int t = 0; t < nt; t += 2) {
            const bool last = (t == nt - 2);
            const char* a1 = cA + (size_t)(t + 1) * kstep;
            const char* a2 = last ? nA : cA + (size_t)(t + 2) * kstep; const char* b2 = last ? nB : cB + (size_t)(t + 2) * kstep;
            const char* a3 = a2 + kstep; const char* b3 = b2 + kstep;
            if (last && has_next) S.a_ready(nxt);
            if constexpr (SP2) {
            PG8_LDB(B0, 0, 0); PG8_LDB(B1, 0, 1); PG8_SCHED; PG8_LDA(At, 0, 0); PG8_STAGE(PG8_SA(1, 1), a1 + hstep, voffA);
            PG8_WAIT_V(8); PG8_WAIT_L(0); PG8_BAR; PG8_MMA(0, 0, At, B0); PG8_MMA(0, 1, At, B1); PG8_BAR; PG8_SCHED;
            PG8_LDA(At, 0, 1); PG8_STAGE(PG8_SB(0, 0), b2, voffB); PG8_STAGE(PG8_SB(0, 1), b2 + hstep, voffB); PG8_STAGE(PG8_SA(0, 0), a2, voffA);
            PG8_WAIT_V(8); PG8_WAIT_L(0); PG8_BAR; PG8_MMA(1, 0, At, B0); PG8_MMA(1, 1, At, B1); PG8_BAR; PG8_SCHED;
            PG8_LDB(B0, 1, 0); PG8_LDB(B1, 1, 1); PG8_SCHED; PG8_LDA(At, 1, 0); PG8_STAGE(PG8_SA(0, 1), a2 + hstep, voffA);
            PG8_WAIT_V(8); PG8_WAIT_L(0); PG8_BAR; PG8_MMA(0, 0, At, B0); PG8_MMA(0, 1, At, B1); PG8_BAR; PG8_SCHED;
            PG8_LDA(At, 1, 1); PG8_STAGE(PG8_SB(1, 0), b3, voffB); PG8_STAGE(PG8_SB(1, 1), b3 + hstep, voffB); PG8_STAGE(PG8_SA(1, 0), a3, voffA);
            PG8_WAIT_V(8); PG8_WAIT_L(0); PG8_BAR; PG8_MMA(1, 0, At, B0); PG8_MMA(1, 1, At, B1); PG8_BAR; PG8_SCHED;
            } else {
            PG8_LDB(B0, 0, 0); PG8_SCHED; PG8_LDA(At, 0, 0); PG8_STAGE(PG8_SA(1, 1), a1 + hstep, voffA);
            PG8_WAIT_L(8); PG8_BAR; PG8_WAIT_L(0); PG8_MMA(0, 0, At, B0); PG8_BAR; PG8_SCHED;
            PG8_LDB(B1, 0, 1); PG8_STAGE(PG8_SB(0, 0), b2, voffB);
            PG8_BAR; PG8_WAIT_L(0); PG8_MMA(0, 1, At, B1); PG8_BAR;
            PG8_LDA(At, 0, 1); PG8_STAGE(PG8_SA(0, 0), a2, voffA);
            PG8_BAR; PG8_WAIT_L(0); PG8_MMA(1, 0, At, B0); PG8_BAR; PG8_SCHED;
            PG8_STAGE(PG8_SB(0, 1), b2 + hstep, voffB);
            PG8_WAIT_V(6); PG8_BAR; PG8_MMA(1, 1, At, B1); PG8_BAR;
            PG8_LDB(B0, 1, 0); PG8_SCHED; PG8_LDA(At, 1, 0); PG8_STAGE(PG8_SA(0, 1), a2 + hstep, voffA);
            PG8_WAIT_L(8); PG8_BAR; PG8_WAIT_L(0); PG8_MMA(0, 0, At, B0); PG8_BAR; PG8_SCHED;
            PG8_LDB(B1, 1, 1); PG8_STAGE(PG8_SB(1, 0), b3, voffB);
            PG8_BAR; PG8_WAIT_L(0); PG8_MMA(0, 1, At, B1); PG8_BAR;
            PG8_LDA(At, 1, 1); PG8_STAGE(PG8_SA(1, 0), a3, voffA);
            PG8_BAR; PG8_WAIT_L(0); PG8_MMA(1, 0, At, B0); PG8_BAR; PG8_SCHED;
            PG8_STAGE(PG8_SB(1, 1), b3 + hstep, voffB);
            PG8_WAIT_V(6); PG8_BAR; PG8_MMA(1, 1, At, B1); PG8_BAR;
            }
        }
        if constexpr (ALIGN_EPI) { if (wr == 0) PG8_BAR; }
        if constexpr (!Epi::AFTER_DRAIN) { E(acc, cur, wr, wc, fr, fq, lds + STAGE_BYTES + wid * EPI_WAVE_BYTES); S.done(cur); }
        if (!has_next) break;
#pragma unroll
        for (int a = 0; a < 2; ++a)
#pragma unroll
            for (int b = 0; b < 2; ++b)
#pragma unroll
                for (int m = 0; m < 4; ++m)
#pragma unroll
                    for (int n = 0; n < 2; ++n) acc[a][b][m][n] = (f32x4){0.f, 0.f, 0.f, 0.f};
        cur = nxt; cA = nA; cB = nB; ++ui;
        if constexpr (ALIGN_EPI) { if (wr == 1) PG8_BAR; }
    }
    PG8_WAIT_V(0);
    if constexpr (!ALIGN_EPI) { if (wr == 0) PG8_BAR; }
    PG8_BAR;
#undef PG8_SA
#undef PG8_SB
#undef PG8_STAGE
#undef PG8_LDA
#undef PG8_LDB
#undef PG8_MMA
#undef PG8_WAIT_V
#undef PG8_WAIT_L
#undef PG8_BAR
#undef PG8_SCHED
}
}

#define XB_TMO      128
#define XB_XCNT(j)  (256  + 64 * (j))
#define XB_XSUB(j)  (1280 + 64 * (j))
#define XB_XGEN(j)  (2304 + 64 * (j))
#define XB_TOP      3328
#define XB_TOPGEN   3392
#define XCD_BAR_WORDS 3456
#define XB_SPIN_CAP (1u << 18)

__device__ __forceinline__ unsigned xb_ld(unsigned* p)              { return __hip_atomic_load(p, __ATOMIC_RELAXED, __HIP_MEMORY_SCOPE_AGENT); }
__device__ __forceinline__ unsigned xb_add(unsigned* p, unsigned v) { return __hip_atomic_fetch_add(p, v, __ATOMIC_RELAXED, __HIP_MEMORY_SCOPE_AGENT); }
__device__ __forceinline__ unsigned xb_xcc_id() { return (unsigned)__builtin_amdgcn_s_getreg((3 << 11) | 20) & 0xFu; }
#define XB_SPIN(cond, bar) do { unsigned _sp = 0; while (cond) { __builtin_amdgcn_s_sleep(1); \
    if ((++_sp & 255u) == 0u) { if (xb_ld(&(bar)[XB_TMO])) break; if (_sp > XB_SPIN_CAP) { atomicAdd(&(bar)[XB_TMO], 1u); break; } } } } while (0)

struct XcdBarrier {
    unsigned* bar; unsigned x;
    volatile LAS unsigned* st;
};

__device__ __forceinline__ XcdBarrier xcd_barrier_post(unsigned* bar, volatile LAS unsigned* st) {
    XcdBarrier b; b.bar = bar; b.x = xb_xcc_id(); b.st = st;
    if (threadIdx.x == 0) (void)xb_add(&bar[XB_XCNT(b.x)], 1u);
    return b;
}
__device__ __forceinline__ void xcd_barrier_complete(unsigned* bar, unsigned x, unsigned& nloc, unsigned& nx) {
    const unsigned G = gridDim.x * gridDim.y * gridDim.z;
    unsigned sum, cnt, mine, sp = 0u;
    for (;;) {
        sum = 0u; cnt = 0u; mine = 0u;
#pragma unroll
        for (unsigned j = 0; j < 16; ++j) { const unsigned c = xb_ld(&bar[XB_XCNT(j)]); sum += c; cnt += (c > 0u) ? 1u : 0u; mine = (j == x) ? c : mine; }
        if (sum == G) break;
        __builtin_amdgcn_s_sleep(1);
        if ((++sp & 255u) == 0u) { if (xb_ld(&bar[XB_TMO])) break; if (sp > XB_SPIN_CAP) { atomicAdd(&bar[XB_TMO], 1u); break; } }
    }
    nloc = mine > 0u ? mine : 1u; nx = cnt > 0u ? cnt : 1u;
}

__device__ __forceinline__ void xcd_barrier(const XcdBarrier& b) {
    asm volatile("s_waitcnt vmcnt(0)" ::: "memory");
    __syncthreads();
    if (threadIdx.x == 0) {
        unsigned* bar = b.bar;
        __builtin_amdgcn_s_waitcnt(0);
        unsigned nloc = b.st[0], nx = b.st[1];
        if (nloc == 0u) { xcd_barrier_complete(bar, b.x, nloc, nx); b.st[0] = nloc; b.st[1] = nx; }
        const unsigned old = xb_add(&bar[XB_XSUB(b.x)], 1u);
        const unsigned gen = old / nloc;
        if (old + 1u == (gen + 1u) * nloc) {
            __builtin_amdgcn_fence(__ATOMIC_RELEASE, "agent");
            asm volatile("s_waitcnt vmcnt(0)" ::: "memory");
            const unsigned og = xb_add(&bar[XB_TOP], 1u);
            const unsigned tg = og / nx;
            if (og + 1u == (tg + 1u) * nx) xb_add(&bar[XB_TOPGEN], 1u);
            else XB_SPIN(xb_ld(&bar[XB_TOPGEN]) == tg, bar);
            __builtin_amdgcn_fence(__ATOMIC_ACQUIRE, "agent");
            xb_add(&bar[XB_XGEN(b.x)], 1u);
            asm volatile("s_waitcnt vmcnt(0)" ::: "memory");
        } else {
            XB_SPIN(xb_ld(&bar[XB_XGEN(b.x)]) == gen, bar);
            __builtin_amdgcn_fence(__ATOMIC_ACQUIRE, "agent");
            asm volatile("s_waitcnt vmcnt(0)" ::: "memory");
        }
    }
    __syncthreads();
}

constexpr int NWAVES = 8, NTHREADS = NWAVES * 64;
constexpr int RING_BYTES = 131072, BARST_OFF = RING_BYTES + 8 * pg8::EPI_WAVE_BYTES, LDS_BYTES = BARST_OFF + 64;

__device__ __forceinline__ void transpose_item(const float* W, int N, bf16_t* WT, int ldt, int k0, int n0, int drow0, LAS float* scr, int lane) {
    float wv[32];
#pragma unroll
    for (int i = 0; i < 32; ++i) { const int kk = 2 * i + (lane >> 5); wv[i] = W[(size_t)(k0 + kk) * N + n0 + (lane & 31)]; }
#pragma unroll
    for (int i = 0; i < 32; ++i) { const int kk = 2 * i + (lane >> 5); scr[kk * 33 + (lane & 31)] = wv[i]; }
    asm volatile("s_waitcnt lgkmcnt(0)" ::: "memory");
    const int c = lane & 7;
#pragma unroll
    for (int j = 0; j < 4; ++j) { const int n = (lane >> 3) + 8 * j; const LAS float* s = scr + (8 * c) * 33 + n;
        u32x4 o; o.x = pk_bf16(s[0 * 33], s[1 * 33]); o.y = pk_bf16(s[2 * 33], s[3 * 33]); o.z = pk_bf16(s[4 * 33], s[5 * 33]); o.w = pk_bf16(s[6 * 33], s[7 * 33]);
        *(u32x4*)(WT + (size_t)(drow0 + n) * ldt + k0 + 8 * c) = o; }
    asm volatile("s_waitcnt lgkmcnt(0)" ::: "memory");
}

struct Args { const float* in[17]; float* out; unsigned char* ws; int ph_lo, ph_hi; };

__device__ __forceinline__ void p0_weights(const Args& a, LAS unsigned char* lds, int gw, int NGW, int wave, int lane, int gtid, int NGT) {
    LAS float* scr = (LAS float*)(lds + wave * 16384);
    unsigned char* ws = a.ws;
    constexpr int I_G = (DM / 64) * (DFF / 32);
    constexpr int I_D = (DFF / 64) * (DM / 32);
    constexpr int I_IN = (DM / 64) * (DIN / 32);
    constexpr int I_OUT = (DM / 64) * (DM / 32);
    constexpr int NITEMS = 2 * (2 * I_G + I_D) + I_IN + I_OUT;
    for (int it = gw; it < NITEMS; it += NGW) {
        int r = it;
        bool done = false;
#pragma unroll
        for (int f = 0; f < 2; ++f) {
            if (done) break;
            const float* Wg = a.in[f ? 13 : 2]; const float* Wu = a.in[f ? 14 : 3]; const float* Wd = a.in[f ? 15 : 4];
            bf16_t* WGU = (bf16_t*)(ws + (f ? WS_WGU2 : WS_WGU1)); bf16_t* WD = (bf16_t*)(ws + (f ? WS_WD2 : WS_WD1));
            if (r < 2 * I_G) { const int up = r >= I_G; const int q = up ? r - I_G : r; const int nblk = DFF / 32, kb = q / nblk, nb = q % nblk, n0 = nb * 32;
                transpose_item(up ? Wu : Wg, DFF, WGU, DM, kb * 64, n0, 256 * (n0 >> 7) + (n0 & 127) + (up ? 128 : 0), scr, lane); done = true; break; }
            r -= 2 * I_G;
            if (r < I_D) { const int nblk = DM / 32, kb = r / nblk, nb = r % nblk; transpose_item(Wd, DM, WD, DFFP, kb * 64, nb * 32, nb * 32, scr, lane); done = true; break; }
            r -= I_D;
        }
        if (done) continue;
        if (r < I_IN) { const int nblk = DIN / 32, kb = r / nblk, nb = r % nblk; transpose_item(a.in[7], DIN, (bf16_t*)(ws + WS_WIN), DM, kb * 64, nb * 32, nb * 32, scr, lane); continue; }
        r -= I_IN;
        { const int nblk = DM / 32, kb = r / nblk, nb = r % nblk; transpose_item(a.in[10], DM, (bf16_t*)(ws + WS_WOUT), DM, kb * 64, nb * 32, nb * 32, scr, lane); }
    }
    for (int f = 0; f < 2; ++f) {
        u32x4* WGU = (u32x4*)(ws + (f ? WS_WGU2 : WS_WGU1)); u32x4* WD = (u32x4*)(ws + (f ? WS_WD2 : WS_WD1));
        for (int i = gtid; i < 128 * 128; i += NGT) { const int pr = i >> 7, c = i & 127; const int row = 256 * 21 + (pr < 64 ? 64 + pr : 128 + pr); WGU[(size_t)row * (DM / 8) + c] = (u32x4){0u, 0u, 0u, 0u}; }
        for (int i = gtid; i < 1024 * 8; i += NGT) { const int row = i >> 3, c = i & 7; WD[(size_t)row * (DFFP / 8) + (DFF / 8) + c] = (u32x4){0u, 0u, 0u, 0u}; }
    }
    { bf16_t* wlt = (bf16_t*)(ws + WS_WLT); const float* wl = a.in[8];
      for (int i = gtid; i < 4 * 64 * 64; i += NGT) { const int g = i >> 12, e = (i >> 6) & 63, c = i & 63; wlt[i] = (bf16_t)(pk_bf16(wl[g * 4096 + c * 64 + e], 0.f) & 0xffffu); } }
}

template <bool XIN_BF, bool HAS_Y, int XOUT, bool WRITE_H>
__device__ __forceinline__ void norm_pass(const void* xin_, const bf16_t* y, const float* gpost, float coef, void* xout_, const float* gnext, bf16_t* hout, int gw, int NGW, int lane) {
    f32x4 gp[4], gn[4];
#pragma unroll
    for (int j = 0; j < 4; ++j) { gp[j] = HAS_Y ? *(const f32x4*)(gpost + 4 * lane + 256 * j) : (f32x4){0.f, 0.f, 0.f, 0.f}; gn[j] = WRITE_H ? *(const f32x4*)(gnext + 4 * lane + 256 * j) : (f32x4){0.f, 0.f, 0.f, 0.f}; }
    f32x4 nv[4]; u32x2 nxr[4]; u32x2 nyr[4];
#define NP_LOAD(r_) do { \
        if constexpr (XIN_BF) { const u32x2* xr = (const u32x2*)((const bf16_t*)xin_ + (size_t)(r_) * DM) + lane; _Pragma("unroll") for (int j = 0; j < 4; ++j) nxr[j] = xr[64 * j]; } \
        else { const f32x4* xr = (const f32x4*)((const float*)xin_ + (size_t)(r_) * DM) + lane; _Pragma("unroll") for (int j = 0; j < 4; ++j) nv[j] = xr[64 * j]; } \
        if constexpr (HAS_Y) { const u32x2* yr = (const u32x2*)(y + (size_t)(r_) * DM) + lane; _Pragma("unroll") for (int j = 0; j < 4; ++j) nyr[j] = yr[64 * j]; } } while (0)
    if (gw < MROWS) NP_LOAD(gw);
    for (int row = gw; row < MROWS; row += NGW) {
        f32x4 v[4]; u32x2 yraw[4];
#pragma unroll
        for (int j = 0; j < 4; ++j) {
            if constexpr (XIN_BF) v[j] = (f32x4){bf_lo(nxr[j].x), bf_hi(nxr[j].x), bf_lo(nxr[j].y), bf_hi(nxr[j].y)}; else v[j] = nv[j];
            if constexpr (HAS_Y) yraw[j] = nyr[j]; }
        const int nrow = row + NGW;
        if (nrow < MROWS) NP_LOAD(nrow);
        if constexpr (HAS_Y) {
            f32x4 yv[4]; float ss = 0.f;
#pragma unroll
            for (int j = 0; j < 4; ++j) { const u32x2 u = yraw[j]; yv[j] = (f32x4){bf_lo(u.x), bf_hi(u.x), bf_lo(u.y), bf_hi(u.y)}; ss += (yv[j].x * yv[j].x + yv[j].y * yv[j].y) + (yv[j].z * yv[j].z + yv[j].w * yv[j].w); }
            const float r = coef * __builtin_amdgcn_rsqf(wave_sum(ss) * (1.0f / DM) + RMS_EPS);
#pragma unroll
            for (int j = 0; j < 4; ++j) v[j] = v[j] + yv[j] * gp[j] * r;
        }
        if constexpr (XOUT == 1) {
            f32x4* xo = (f32x4*)((float*)xout_ + (size_t)row * DM) + lane;
#pragma unroll
            for (int j = 0; j < 4; ++j) xo[64 * j] = v[j];
        }
        if constexpr (XOUT == 2) {
            u32x2* xo = (u32x2*)((bf16_t*)xout_ + (size_t)row * DM) + lane;
#pragma unroll
            for (int j = 0; j < 4; ++j) xo[64 * j] = (u32x2){pk_bf16(v[j].x, v[j].y), pk_bf16(v[j].z, v[j].w)};
        }
        if constexpr (WRITE_H) {
            float ss = 0.f;
#pragma unroll
            for (int j = 0; j < 4; ++j) ss += (v[j].x * v[j].x + v[j].y * v[j].y) + (v[j].z * v[j].z + v[j].w * v[j].w);
            const float r = __builtin_amdgcn_rsqf(wave_sum(ss) * (1.0f / DM) + RMS_EPS);
            u32x2* ho = (u32x2*)(hout + (size_t)row * DM) + lane;
#pragma unroll
            for (int j = 0; j < 4; ++j) { const f32x4 h = v[j] * gn[j] * r; ho[64 * j] = (u32x2){pk_bf16(h.x, h.y), pk_bf16(h.z, h.w)}; }
        }
    }
#undef NP_LOAD
}

template <int GI>
__device__ __forceinline__ void pool_task(const bf16_t* z, const bf16_t* wlt, const float* pscale, bf16_t* mix, int strip, int lane) {
    constexpr int HW = 1 << GI, WN = 2 * HW;
    const int fr = lane & 15, fq = lane >> 4;
    const int row = strip * 16 + fr, t = row & (SEQ - 1), bbase = row - t;
    const int lo = max(t - HW, 0), hi = min(t + HW, SEQ);
    const float inv = 1.0f / (float)(hi - lo);
    bf16x8 yb[2];
#pragma unroll
    for (int kk = 0; kk < 2; ++kk) {
        const int c0 = GI * 64 + 8 * fq + 32 * kk;
        u32x4 ld[WN];
#pragma unroll
        for (int i = 0; i < WN; ++i) { const int tt = min(max(t - HW + i, 0), SEQ - 1); ld[i] = *(const u32x4*)(z + (size_t)(bbase + tt) * DIN + c0); }
        float s[8];
#pragma unroll
        for (int e = 0; e < 8; ++e) s[e] = 0.f;
#pragma unroll
        for (int i = 0; i < WN; ++i) { const int tt = t - HW + i; const float mk = (tt >= 0 && tt < SEQ) ? 1.0f : 0.0f; const u32x4 u = ld[i];
            s[0] += mk * bf_lo(u.x); s[1] += mk * bf_hi(u.x); s[2] += mk * bf_lo(u.y); s[3] += mk * bf_hi(u.y); s[4] += mk * bf_lo(u.z); s[5] += mk * bf_hi(u.z); s[6] += mk * bf_lo(u.w); s[7] += mk * bf_hi(u.w); }
        const u32x4 u = ld[HW];
        u32x4 p; p.x = pk_bf16(s[0] * inv - bf_lo(u.x), s[1] * inv - bf_hi(u.x)); p.y = pk_bf16(s[2] * inv - bf_lo(u.y), s[3] * inv - bf_hi(u.y));
        p.z = pk_bf16(s[4] * inv - bf_lo(u.z), s[5] * inv - bf_hi(u.z)); p.w = pk_bf16(s[6] * inv - bf_lo(u.w), s[7] * inv - bf_hi(u.w));
        yb[kk] = __builtin_bit_cast(bf16x8, p);
    }
#pragma unroll
    for (int eb = 0; eb < 4; ++eb) {
        f32x4 acc = {0.f, 0.f, 0.f, 0.f};
#pragma unroll
        for (int kk = 0; kk < 2; ++kk) { const bf16x8 wa = *(const bf16x8*)(wlt + (size_t)GI * 4096 + (16 * eb + fr) * 64 + 8 * fq + 32 * kk);
            acc = __builtin_amdgcn_mfma_f32_16x16x32_bf16(wa, yb[kk], acc, 0, 0, 0); }
        const f32x4 sc = *(const f32x4*)(pscale + GI * 64 + 16 * eb + 4 * fq);
        acc = acc * sc;
        *(u32x2*)(mix + (size_t)row * DM + GI * 64 + 16 * eb + 4 * fq) = (u32x2){pk_bf16(acc.x, acc.y), pk_bf16(acc.z, acc.w)};
    }
}
__device__ __forceinline__ void pool_phase(const bf16_t* z, const bf16_t* wlt, const float* pscale, bf16_t* mix, int gw, int NGW, int lane) {
    for (int strip = gw; strip < MROWS / 16; strip += NGW) {
        pool_task<0>(z, wlt, pscale, mix, strip, lane); pool_task<1>(z, wlt, pscale, mix, strip, lane);
        pool_task<2>(z, wlt, pscale, mix, strip, lane); pool_task<3>(z, wlt, pscale, mix, strip, lane);
    }
}

constexpr int AT_PITCH = 144, AT_ROWS = 272, AT_KOFF = 0, AT_VOFF = AT_ROWS * AT_PITCH;
struct AtUnit { int h, dsh, L, n0; size_t rowbase; };
__device__ __forceinline__ AtUnit at_decode(int unit) {
    AtUnit u; const int bh = unit >> 6, j = unit & 63, b = bh / NHEAD; u.h = bh - b * NHEAD; const int g = u.h >> 2;
    u.dsh = 2 * g; u.L = SEQ >> u.dsh;
    const int r = j >> (6 - u.dsh), c = j & ((64 >> u.dsh) - 1); u.n0 = c * 128; u.rowbase = (size_t)b * SEQ + r; return u;
}
__device__ __forceinline__ void at_fetch(const bf16_t* z, const AtUnit& u, int tid, int w, int fr, int fq, u32x4 (&kv)[4], u32x4 (&vv)[4], bf16x8 (&qf)[2]) {
#pragma unroll
    for (int i = 0; i < 4; ++i) { const int id = tid + NTHREADS * i, row = id >> 3, ch = id & 7, n = u.n0 - 64 + row;
        kv[i] = (u32x4){0u, 0u, 0u, 0u}; vv[i] = kv[i];
        if (n >= 0 && n < u.L) { const bf16_t* src = z + (u.rowbase + ((size_t)n << u.dsh)) * DIN + u.h * 64 + ch * 8; kv[i] = *(const u32x4*)(src + KOFF_Z); vv[i] = *(const u32x4*)(src + VOFF_Z); } }
    const size_t qrow = u.rowbase + ((size_t)(u.n0 + 16 * w + fr) << u.dsh);
#pragma unroll
    for (int kk = 0; kk < 2; ++kk) qf[kk] = *(const bf16x8*)(z + qrow * DIN + QOFF + u.h * 64 + 8 * fq + 32 * kk);
}
__device__ __forceinline__ void attn_phase(LAS unsigned char* lds, const bf16_t* z, bf16_t* mix, float* lse, int G, int bid, int tid) {
    const int lane = tid & 63, w = __builtin_amdgcn_readfirstlane(tid >> 6), fr = lane & 15, fq = lane >> 4;
    constexpr int NUNITS = BATCH * NHEAD * 64;
    for (int i = tid; i < 16 * AT_PITCH / 4; i += NTHREADS) { ((LAS unsigned*)(lds + AT_VOFF + 256 * AT_PITCH))[i] = 0u; ((LAS unsigned*)(lds + AT_KOFF + 256 * AT_PITCH))[i] = 0u; }
    u32x4 kv[4], vv[4]; bf16x8 qn[2];
    if (bid < NUNITS) { const AtUnit u0 = at_decode(bid); at_fetch(z, u0, tid, w, fr, fq, kv, vv, qn); }
    for (int unit = bid; unit < NUNITS; unit += G) {
        const AtUnit u = at_decode(unit);
        const int h = u.h, dsh = u.dsh, L = u.L, n0 = u.n0;
        __syncthreads();
#pragma unroll
        for (int i = 0; i < 4; ++i) { const int id = tid + NTHREADS * i, row = id >> 3, ch = id & 7;
            *(LAS u32x4*)(lds + AT_KOFF + row * AT_PITCH + ch * 16) = kv[i]; *(LAS u32x4*)(lds + AT_VOFF + row * AT_PITCH + ch * 16) = vv[i]; }
        bf16x8 qf[2]; qf[0] = qn[0]; qf[1] = qn[1];
        const size_t qrow = u.rowbase + ((size_t)(n0 + 16 * w + fr) << dsh);
        __syncthreads();
        if (unit + G < NUNITS) { const AtUnit un = at_decode(unit + G); at_fetch(z, un, tid, w, fr, fq, kv, vv, qn); }
        f32x4 s[9];
#pragma unroll
        for (int kt = 0; kt < 9; ++kt) {
            const LAS unsigned char* kp = lds + AT_KOFF + (16 * w + 16 * kt + fr) * AT_PITCH + 16 * fq;
            const bf16x8 a0 = *(const LAS bf16x8*)kp, a1 = *(const LAS bf16x8*)(kp + 64);
            f32x4 acc = {0.f, 0.f, 0.f, 0.f};
            acc = __builtin_amdgcn_mfma_f32_16x16x32_bf16(a0, qf[0], acc, 0, 0, 0);
            acc = __builtin_amdgcn_mfma_f32_16x16x32_bf16(a1, qf[1], acc, 0, 0, 0);
            s[kt] = acc;
        }
        const float c1 = 0.125f * 1.44269504089f;
        const float c2 = exp2f(-8.0f * (float)(h + 1) / 12.0f) * (float)(1 << dsh) * 1.44269504089f;
        float mx = -INFINITY;
#pragma unroll
        for (int kt = 0; kt < 9; ++kt)
#pragma unroll
            for (int e = 0; e < 4; ++e) {
                const int rel = 16 * kt + 4 * fq + e - 64 - fr;
                const int nk = n0 + 16 * w + fr + rel;
                const bool ok = (rel >= -64) && (rel <= 64) && (nk >= 0) && (nk < L);
                const float v = ok ? s[kt][e] * c1 - c2 * (float)(rel < 0 ? -rel : rel) : -INFINITY;
                s[kt][e] = v; mx = fmaxf(mx, v);
            }
        mx = fmaxf(mx, __shfl_xor(mx, 16)); mx = fmaxf(mx, __shfl_xor(mx, 32));
        float sum = 0.f;
#pragma unroll
        for (int kt = 0; kt < 9; ++kt)
#pragma unroll
            for (int e = 0; e < 4; ++e) { const float p = __builtin_amdgcn_exp2f(s[kt][e] - mx); s[kt][e] = p; sum += p; }
        sum += __shfl_xor(sum, 16); sum += __shfl_xor(sum, 32);
        f32x4 o[4];
#pragma unroll
        for (int db = 0; db < 4; ++db) o[db] = (f32x4){0.f, 0.f, 0.f, 0.f};
        const int tq = (lane & 15) >> 2, tp = lane & 3;
#pragma unroll
        for (int cc = 0; cc < 5; ++cc) {
            u32x4 pp; pp.x = pk_bf16(s[2 * cc][0], s[2 * cc][1]); pp.y = pk_bf16(s[2 * cc][2], s[2 * cc][3]);
            if (cc < 4) { pp.z = pk_bf16(s[2 * cc + 1][0], s[2 * cc + 1][1]); pp.w = pk_bf16(s[2 * cc + 1][2], s[2 * cc + 1][3]); } else { pp.z = 0u; pp.w = 0u; }
            const bf16x8 pb = __builtin_bit_cast(bf16x8, pp);
            const LAS unsigned char* vp = lds + AT_VOFF + (16 * w + 32 * cc + 4 * fq + tq) * AT_PITCH + 8 * tp;
#pragma unroll
            for (int db = 0; db < 4; ++db) {
                const s16x4 v0 = __builtin_amdgcn_ds_read_tr16_b64_v4i16((LAS s16x4*)(vp + 32 * db));
                const s16x4 v1 = __builtin_amdgcn_ds_read_tr16_b64_v4i16((LAS s16x4*)(vp + 16 * AT_PITCH + 32 * db));
                const bf16x8 va = {v0[0], v0[1], v0[2], v0[3], v1[0], v1[1], v1[2], v1[3]};
                o[db] = __builtin_amdgcn_mfma_f32_16x16x32_bf16(va, pb, o[db], 0, 0, 0);
            }
        }
        const float inv = 1.0f / sum;
        bf16_t* op = mix + qrow * DM + 256 + h * 64 + 4 * fq;
#pragma unroll
        for (int db = 0; db < 4; ++db) { const f32x4 v = o[db] * inv; *(u32x2*)(op + 16 * db) = (u32x2){pk_bf16(v.x, v.y), pk_bf16(v.z, v.w)}; }
        if (fq == 0) lse[qrow * NHEAD + h] = (mx + __builtin_amdgcn_logf(sum)) * 0.69314718056f;
    }
    __syncthreads();
}

__device__ __forceinline__ void alpha_pass(bf16_t* mix, const float* lse, int gw, int NGW, int lane) {
    const int hg = lane >> 4;
    for (int row = gw; row < MROWS; row += NGW) {
        const float* lr = lse + (size_t)row * NHEAD;
        const float l0 = lr[hg], l1 = lr[4 + hg], l2 = lr[8 + hg];
        const float m = fmaxf(l0, fmaxf(l1, l2));
        const float e0 = __expf(l0 - m), e1 = __expf(l1 - m), e2 = __expf(l2 - m);
        const float inv = 1.0f / (e0 + e1 + e2);
        const float al[3] = {e0 * inv, e1 * inv, e2 * inv};
        u32x2* p = (u32x2*)(mix + (size_t)row * DM + 256) + lane;
#pragma unroll
        for (int i = 0; i < 3; ++i) { const u32x2 u = p[64 * i]; const float a = al[i];
            p[64 * i] = (u32x2){pk_bf16(bf_lo(u.x) * a, bf_hi(u.x) * a), pk_bf16(bf_lo(u.y) * a, bf_hi(u.y) * a)}; }
    }
}

__global__ void __launch_bounds__(NTHREADS, 2) fwd_kernel(Args args) {
    extern __shared__ __attribute__((aligned(16))) unsigned char lds_raw[];
    LAS unsigned char* lds = (LAS unsigned char*)lds_raw;
    cg::grid_group grid = cg::this_grid();
    const int tid = threadIdx.x, lane = tid & 63, wave = __builtin_amdgcn_readfirstlane(tid >> 6);
    const int G = gridDim.x, bid = blockIdx.x;
    const int gw = bid * NWAVES + wave, NGW = G * NWAVES, gtid = bid * NTHREADS + tid, NGT = G * NTHREADS;
    unsigned char* ws = args.ws;
    bf16_t* WGU1 = (bf16_t*)(ws + WS_WGU1); bf16_t* WD1 = (bf16_t*)(ws + WS_WD1); bf16_t* WIN = (bf16_t*)(ws + WS_WIN); bf16_t* WOUT = (bf16_t*)(ws + WS_WOUT);
    bf16_t* WGU2 = (bf16_t*)(ws + WS_WGU2); bf16_t* WD2 = (bf16_t*)(ws + WS_WD2); bf16_t* WLT = (bf16_t*)(ws + WS_WLT);
    float* LSE = (float*)(ws + WS_LSE);
    bf16_t* HB = (bf16_t*)(ws + WS_H); bf16_t* YB = (bf16_t*)(ws + WS_Y); bf16_t* AB = (bf16_t*)(ws + WS_A); bf16_t* ZB = AB; bf16_t* XB = (bf16_t*)(ws + WS_XB);
    const float* x = args.in[0]; float* out = args.out;
    const int lo = args.ph_lo, hi = args.ph_hi;
    if (tid < 16) ((LAS unsigned*)(lds + BARST_OFF))[tid] = 0u;
    __syncthreads();
    XcdBarrier bar = xcd_barrier_post((unsigned*)(ws + WS_CTL), (volatile LAS unsigned*)(lds + BARST_OFF));
    if (lo < 0) grid.sync();
#define IN(k) (lo <= (k) && (k) < hi)
#define SEAM(k) do { if (IN(k) && IN((k) + 1)) xcd_barrier(bar); } while (0)

    if (IN(0)) { p0_weights(args, lds, gw, NGW, wave, lane, gtid, NGT);
        norm_pass<false, false, 0, true>(x, nullptr, nullptr, 0.f, nullptr, args.in[1], HB, gw, NGW, lane); }
    SEAM(0);
    if (IN(1)) { pg8::Gemm g{HB, WGU1, MROWS, NGU, DM}; pg8::StaticOrder S; S.init(MROWS, NGU, G, bid); pg8::EpiSwiGLU E{AB, DFFP};
        pg8::gemm_phase<pg8::EpiSwiGLU, pg8::StaticOrder, true, true>(lds, g, S, E); }
    SEAM(1);
    if (IN(2)) { pg8::Gemm g{AB, WD1, MROWS, DM, DFFP}; pg8::StaticOrder S; S.init(MROWS, DM, G, bid); pg8::EpiBf16 E{YB, DM};
        pg8::gemm_phase<pg8::EpiBf16, pg8::StaticOrder, true, true>(lds, g, S, E); }
    SEAM(2);
    if (IN(3)) norm_pass<false, true, 2, true>(x, YB, args.in[5], 0.5f, XB, args.in[6], HB, gw, NGW, lane);
    SEAM(3);
    if (IN(4)) { pg8::Gemm g{HB, WIN, MROWS, DIN, DM}; pg8::StaticOrder S; S.init(MROWS, DIN, G, bid); pg8::EpiBf16 E{ZB, DIN};
        pg8::gemm_phase<pg8::EpiBf16, pg8::StaticOrder, true, true>(lds, g, S, E); }
    SEAM(4);
    if (IN(5)) { pool_phase(ZB, WLT, args.in[9], HB, gw, NGW, lane); attn_phase(lds, ZB, HB, LSE, G, bid, tid); }
    SEAM(5);
    if (IN(6)) alpha_pass(HB, LSE, gw, NGW, lane);
    SEAM(6);
    if (IN(7)) { pg8::Gemm g{HB, WOUT, MROWS, DM, DM}; pg8::StaticOrder S; S.init(MROWS, DM, G, bid); pg8::EpiBf16 E{YB, DM};
        pg8::gemm_phase<pg8::EpiBf16, pg8::StaticOrder, true, true>(lds, g, S, E); }
    SEAM(7);
    if (IN(8)) norm_pass<true, true, 2, true>(XB, YB, args.in[11], 1.0f, XB, args.in[12], HB, gw, NGW, lane);
    SEAM(8);
    if (IN(9)) { pg8::Gemm g{HB, WGU2, MROWS, NGU, DM}; pg8::StaticOrder S; S.init(MROWS, NGU, G, bid); pg8::EpiSwiGLU E{AB, DFFP};
        pg8::gemm_phase<pg8::EpiSwiGLU, pg8::StaticOrder, true, true>(lds, g, S, E); }
    SEAM(9);
    if (IN(10)) { pg8::Gemm g{AB, WD2, MROWS, DM, DFFP}; pg8::StaticOrder S; S.init(MROWS, DM, G, bid); pg8::EpiBf16 E{YB, DM};
        pg8::gemm_phase<pg8::EpiBf16, pg8::StaticOrder, true, true>(lds, g, S, E); }
    SEAM(10);
    if (IN(11)) norm_pass<true, true, 1, false>(XB, YB, args.in[16], 0.5f, out, nullptr, nullptr, gw, NGW, lane);
#undef IN
#undef SEAM
}

constexpr int NPHASES = 12;
#ifndef MK_PER_PHASE
#define MK_PER_PHASE 0
#endif

extern "C" void kernel_launch(void* const* d_in, const int* in_sizes, int n_in, void* d_out, int out_size, void* d_ws, size_t ws_size, hipStream_t stream) {
    static int grid = 0;
    if (grid == 0) {
        if (n_in != 17 || out_size != MROWS * DM || ws_size < WS_END) { fprintf(stderr, "kernel_launch: unexpected shapes (n_in %d out %d ws %zu)\n", n_in, out_size, ws_size); grid = -1; return; }
        int dev = 0, cus = 0, per_cu = 0;
        hipGetDevice(&dev);
        hipDeviceGetAttribute(&cus, hipDeviceAttributeMultiprocessorCount, dev);
        if (hipFuncSetAttribute((const void*)fwd_kernel, hipFuncAttributeMaxDynamicSharedMemorySize, LDS_BYTES) != hipSuccess) { fprintf(stderr, "kernel_launch: hipFuncSetAttribute failed\n"); grid = -1; return; }
        if (hipOccupancyMaxActiveBlocksPerMultiprocessor(&per_cu, (const void*)fwd_kernel, NTHREADS, LDS_BYTES) != hipSuccess || per_cu < 1) { fprintf(stderr, "kernel_launch: occupancy query gave %d\n", per_cu); per_cu = 1; }
        (void)hipGetLastError();
        grid = cus * per_cu;
        fprintf(stderr, "kernel_launch: cus %d per_cu %d grid %d\n", cus, per_cu, grid);
    }
    if (grid < 0) return;
    Args a{};
    for (int i = 0; i < 17; ++i) a.in[i] = (const float*)d_in[i];
    a.out = (float*)d_out; a.ws = (unsigned char*)d_ws;
#if MK_PER_PHASE
    for (int p = 0; p < NPHASES; ++p) { a.ph_lo = p; a.ph_hi = p + 1; hipLaunchKernelGGL(fwd_kernel, dim3(grid), dim3(NTHREADS), LDS_BYTES, stream, a); }
#else
    a.ph_lo = 0; a.ph_hi = NPHASES;
    if (hipMemsetAsync((char*)d_ws + WS_CTL, 0, CTL_BYTES, stream) != hipSuccess) { fprintf(stderr, "kernel_launch: memset failed\n"); return; }
    void* kargs[] = {&a};
    hipError_t e = hipLaunchCooperativeKernel((const void*)fwd_kernel, dim3(grid), dim3(NTHREADS), kargs, LDS_BYTES, stream);
    if (e != hipSuccess) fprintf(stderr, "kernel_launch: cooperative launch failed: %s (grid %d)\n", hipGetErrorString(e), grid);
#endif
}
```

```cpp
#include <hip/hip_runtime.h>
#include <hip/hip_cooperative_groups.h>
#include <cstdio>
#include <cstdint>
namespace cg = cooperative_groups;

#define LAS __attribute__((address_space(3)))
typedef unsigned short bf16_t;
typedef short bf16x8 __attribute__((ext_vector_type(8)));
typedef short s16x4 __attribute__((ext_vector_type(4)));
typedef float f32x4 __attribute__((ext_vector_type(4)));
typedef float f32x2 __attribute__((ext_vector_type(2)));
typedef unsigned u32x4 __attribute__((ext_vector_type(4)));
typedef unsigned u32x2 __attribute__((ext_vector_type(2)));
typedef __bf16 bf16v2 __attribute__((ext_vector_type(2)));

constexpr int BATCH = 8, SEQ = 8192, DM = 1024, MROWS = BATCH * SEQ;
constexpr int DFF = 2752, DFFP = 2816;
constexpr int NGU = 2 * DFFP;
constexpr int DIN = 2560, NHEAD = 12;
constexpr int QOFF = 256, KOFF_Z = 1024, VOFF_Z = 1792;
constexpr float RMS_EPS = 1e-6f;
constexpr float QSCALE = 0.125f * 1.44269504089f;

constexpr size_t MiB = 1u << 20;
constexpr size_t WS_WGU1 = 0, WS_WD1 = 12 * MiB, WS_WIN = 18 * MiB, WS_WOUT = 24 * MiB, WS_WGU2 = 26 * MiB, WS_WD2 = 38 * MiB, WS_WLT = 44 * MiB;
constexpr size_t WS_CTL = 48 * MiB, CTL_BYTES = 16384;
constexpr size_t WS_RINV = 50 * MiB;
constexpr size_t WS_LSE = 45 * MiB;
constexpr size_t WS_H = 64 * MiB;
constexpr size_t WS_Y = 192 * MiB;
constexpr size_t WS_A = 320 * MiB;
constexpr size_t WS_XB = 672 * MiB;
constexpr size_t WS_END = 800 * MiB;
static_assert((size_t)NGU * DM * 2 <= 12 * MiB && (size_t)DM * DFFP * 2 <= 6 * MiB && (size_t)DIN * DM * 2 <= 6 * MiB, "weight map");

__device__ __forceinline__ unsigned pk_bf16(float lo, float hi) { f32x2 v = {lo, hi}; bf16v2 c = __builtin_convertvector(v, bf16v2); return __builtin_bit_cast(unsigned, c); }
__device__ __forceinline__ float bf_lo(unsigned u) { return __uint_as_float(u << 16); }
__device__ __forceinline__ float bf_hi(unsigned u) { return __uint_as_float(u & 0xffff0000u); }
__device__ __forceinline__ float wave_sum(float v) {
#pragma unroll
    for (int o = 1; o < 64; o <<= 1) v += __shfl_xor(v, o);
    return v;
}

namespace pg8 {
constexpr int BM = 256, BK = 64, HALF = 128, HTB = HALF * BK * 2, STAGE_BYTES = 8 * HTB, NXCD = 8, WGM = 4;
__host__ __device__ __forceinline__ int lds_byte(int r, int c) { const int st = (r >> 4) * 2 + (c >> 5), rr = r & 15, cc = c & 31, ob = rr * 64 + cc * 2; return st * 1024 + (ob ^ (((ob >> 9) & 1) << 5)); }
__host__ __device__ __forceinline__ void stage_rc(int b, int& R, int& C) { const int st = b / 1024, sb = b % 1024, swz = sb ^ (((sb >> 9) & 1) << 5); R = (st >> 1) * 16 + swz / 64; C = (st & 1) * 32 + (swz % 64) / 2; }
__host__ __device__ __forceinline__ int perm32(int rho) { const int n = rho >> 4, i = rho & 15; return 8 * (i >> 2) + 4 * n + (i & 3); }

struct Unit { int pm, pn; };
struct Gemm { const bf16_t* A; const bf16_t* Bt; int M, N, K; };

struct StaticOrder {
    int nM, nN, nwg, G, c;
    __host__ __device__ void init(int M, int N, int G_, int c_) { nM = M / BM; nN = N / BM; nwg = nM * nN; G = G_; c = c_; }
    __host__ __device__ bool next(int i, Unit& u) const {
        const long L = (long)i * G + c; if (L >= nwg) return false;
        int wgid = (int)L; { const int q = nwg / NXCD, r = nwg % NXCD, xcd = wgid % NXCD, off = wgid / NXCD; wgid = (xcd < r ? xcd * (q + 1) : r * (q + 1) + (xcd - r) * q) + off; }
        const int nig = WGM * nN, gid = wgid / nig, fm = gid * WGM, gsz = (nM - fm) < WGM ? (nM - fm) : WGM;
        u.pm = fm + ((wgid % nig) % gsz); u.pn = (wgid % nig) / gsz; return true;
    }
    __device__ __forceinline__ void a_ready(const Unit&) const {}
    __device__ __forceinline__ void done(const Unit&) const {}
};

constexpr int EPI_PITCH = 144, EPI_WAVE_BYTES = 16 * EPI_PITCH;
struct EpiBf16 {
    static constexpr bool PERM = true, AFTER_DRAIN = false;
    bf16_t* O; int ldc;
    __device__ __forceinline__ void operator()(const f32x4 (&acc)[2][2][4][2], const Unit& u, int wr, int wc, int fr, int fq, LAS unsigned char* stg) const {
        const int lane = fr + 16 * fq, r4 = lane >> 2, c4 = lane & 3;
        bf16_t* base = O + (size_t)(u.pm * BM + wr * 64 + r4) * ldc + u.pn * BM + wc * 32 + c4 * 8;
        LAS unsigned char* wp = stg + fr * EPI_PITCH + fq * 16; const LAS unsigned char* rp = stg + r4 * EPI_PITCH + c4 * 16;
#pragma unroll
        for (int ai = 0; ai < 2; ++ai)
#pragma unroll
            for (int m = 0; m < 4; ++m) {
#pragma unroll
                for (int bj = 0; bj < 2; ++bj) { const f32x4 v0 = acc[ai][bj][m][0], v1 = acc[ai][bj][m][1];
                    u32x4 w; w.x = pk_bf16(v0[0], v0[1]); w.y = pk_bf16(v0[2], v0[3]); w.z = pk_bf16(v1[0], v1[1]); w.w = pk_bf16(v1[2], v1[3]);
                    *(LAS u32x4*)(wp + bj * 64) = w; }
                bf16_t* rowp = base + (size_t)(ai * HALF + m * 16) * ldc;
#pragma unroll
                for (int bj = 0; bj < 2; ++bj) { const u32x4 v = *(const LAS u32x4*)(rp + bj * 64); *(u32x4*)(rowp + bj * HALF) = v; }
            }
    }
};
__device__ __forceinline__ unsigned silu_mul_pk(float g0, float g1, float u0, float u1) {
    const f32x2 g = {g0, g1}, u = {u0, u1}; const f32x2 t = g * -1.44269504089f;
    f32x2 e; e.x = __builtin_amdgcn_exp2f(t.x); e.y = __builtin_amdgcn_exp2f(t.y);
    const f32x2 d = e + 1.0f; f32x2 r; r.x = __builtin_amdgcn_rcpf(d.x); r.y = __builtin_amdgcn_rcpf(d.y);
    const f32x2 o = (g * u) * r; return pk_bf16(o.x, o.y); }
struct EpiSwiGLU {
    static constexpr bool PERM = true, AFTER_DRAIN = false;
    bf16_t* O; int ldc;
    __device__ __forceinline__ void operator()(const f32x4 (&acc)[2][2][4][2], const Unit& u, int wr, int wc, int fr, int fq, LAS unsigned char* stg) const {
        const int lane = fr + 16 * fq, r4 = lane >> 2, c4 = lane & 3;
        bf16_t* base = O + (size_t)(u.pm * BM + wr * 64 + r4) * ldc + u.pn * HALF + wc * 32 + c4 * 8;
        LAS unsigned char* wp = stg + fr * EPI_PITCH + fq * 16; const LAS unsigned char* rp = stg + r4 * EPI_PITCH + c4 * 16;
#pragma unroll
        for (int ai = 0; ai < 2; ++ai)
#pragma unroll
            for (int mp = 0; mp < 2; ++mp) {
#pragma unroll
                for (int mm = 0; mm < 2; ++mm) { const int m = 2 * mp + mm;
                    const f32x4 g0 = acc[ai][0][m][0], g1 = acc[ai][0][m][1], u0 = acc[ai][1][m][0], u1 = acc[ai][1][m][1];
                    u32x4 w; w.x = silu_mul_pk(g0[0], g0[1], u0[0], u0[1]); w.y = silu_mul_pk(g0[2], g0[3], u0[2], u0[3]);
                    w.z = silu_mul_pk(g1[0], g1[1], u1[0], u1[1]); w.w = silu_mul_pk(g1[2], g1[3], u1[2], u1[3]);
                    *(LAS u32x4*)(wp + mm * 64) = w; }
#pragma unroll
                for (int mm = 0; mm < 2; ++mm) { const u32x4 v = *(const LAS u32x4*)(rp + mm * 64); *(u32x4*)(base + (size_t)(ai * HALF + (2 * mp + mm) * 16) * ldc) = v; }
            }
    }
};

template <class Epi, class Sched, bool ALIGN_EPI = false, bool SP2 = false>
__device__ __forceinline__ void gemm_phase(LAS unsigned char* lds, const Gemm g, const Sched& S, const Epi& E) {
    const int tid = threadIdx.x, wid = __builtin_amdgcn_readfirstlane(tid >> 6), lane = tid & 63, wr = wid >> 2, wc = wid & 3, fr = lane & 15, fq = lane >> 4;
    const int K = g.K, nt = K / BK;
    unsigned voffA[2], voffB[2];
#pragma unroll
    for (int i = 0; i < 2; ++i) { int R, C; stage_rc(tid * 16 + i * 8192, R, C); const int Rb = Epi::PERM ? ((R & ~31) + perm32(R & 31)) : R;
        voffA[i] = (unsigned)(R * K + C) * 2u; voffB[i] = (unsigned)(Rb * K + C) * 2u; }
    const size_t kstep = (size_t)(BK * 2);
    const size_t hstep = (size_t)HALF * K * 2;
    const size_t tstep = 2 * hstep;
    const unsigned ldsw = (unsigned)wid * 1024u;
    const int aoff = lds_byte(wr * 64 + fr, fq * 8), boff = lds_byte(wc * 32 + fr, fq * 8);
#define PG8_SA(b, h) (((b) * 2 + (h)) * HTB)
#define PG8_SB(b, h) ((4 + (b) * 2 + (h)) * HTB)
#define PG8_STAGE(bufoff, gbase, voff) do { _Pragma("unroll") for (int _i = 0; _i < 2; ++_i) \
        __builtin_amdgcn_global_load_lds((const unsigned*)((const char*)(gbase) + (voff)[_i]), (LAS unsigned*)(lds + (bufoff) + ldsw + _i * 8192), 16, 0, 0); } while (0)
#define PG8_LDA(dst, b, h) do { _Pragma("unroll") for (int m = 0; m < 4; ++m) _Pragma("unroll") for (int k = 0; k < 2; ++k) dst[m][k] = *(const LAS bf16x8*)(lds + PG8_SA(b, h) + aoff + m * 2048 + k * 1024); } while (0)
#define PG8_LDB(dst, b, h) do { _Pragma("unroll") for (int n = 0; n < 2; ++n) _Pragma("unroll") for (int k = 0; k < 2; ++k) dst[n][k] = *(const LAS bf16x8*)(lds + PG8_SB(b, h) + boff + n * 2048 + k * 1024); } while (0)
#define PG8_MMA(ai, bj, At, Bt) do { __builtin_amdgcn_s_setprio(1); _Pragma("unroll") for (int m = 0; m < 4; ++m) _Pragma("unroll") for (int n = 0; n < 2; ++n) _Pragma("unroll") for (int k = 0; k < 2; ++k) \
        acc[ai][bj][m][n] = __builtin_amdgcn_mfma_f32_16x16x32_bf16(Bt[n][k], At[m][k], acc[ai][bj][m][n], 0, 0, 0); __builtin_amdgcn_s_setprio(0); } while (0)
#define PG8_WAIT_V(n) asm volatile("s_waitcnt vmcnt(" #n ")" ::: "memory")
#define PG8_WAIT_L(n) asm volatile("s_waitcnt lgkmcnt(" #n ")" ::: "memory")
#define PG8_BAR __builtin_amdgcn_s_barrier()
#define PG8_SCHED __builtin_amdgcn_sched_barrier(0)
    Unit cur, nxt; int ui = 0;
    if (!S.next(0, cur)) return;
    f32x4 acc[2][2][4][2];
#pragma unroll
    for (int a = 0; a < 2; ++a)
#pragma unroll
        for (int b = 0; b < 2; ++b)
#pragma unroll
            for (int m = 0; m < 4; ++m)
#pragma unroll
                for (int n = 0; n < 2; ++n) acc[a][b][m][n] = (f32x4){0.f, 0.f, 0.f, 0.f};
    bf16x8 At[4][2], B0[2][2], B1[2][2];
    const char* cA = (const char*)g.A + (size_t)cur.pm * tstep; const char* cB = (const char*)g.Bt + (size_t)cur.pn * tstep;
    S.a_ready(cur);
    if constexpr (SP2) {
        PG8_STAGE(PG8_SB(0, 0), cB, voffB); PG8_STAGE(PG8_SB(0, 1), cB + hstep, voffB); PG8_STAGE(PG8_SA(0, 0), cA, voffA); PG8_STAGE(PG8_SA(0, 1), cA + hstep, voffA);
        if (wr == 1) PG8_BAR;
        PG8_WAIT_V(2); PG8_BAR;
        PG8_STAGE(PG8_SB(1, 0), cB + kstep, voffB); PG8_STAGE(PG8_SA(1, 0), cA + kstep, voffA); PG8_STAGE(PG8_SB(1, 1), cB + hstep + kstep, voffB);
        PG8_WAIT_V(6); PG8_BAR;
    } else {
        PG8_STAGE(PG8_SB(0, 0), cB, voffB); PG8_STAGE(PG8_SA(0, 0), cA, voffA); PG8_STAGE(PG8_SB(0, 1), cB + hstep, voffB); PG8_STAGE(PG8_SA(0, 1), cA + hstep, voffA);
        if (wr == 1) PG8_BAR;
        PG8_WAIT_V(4); PG8_BAR;
        PG8_STAGE(PG8_SB(1, 0), cB + kstep, voffB); PG8_STAGE(PG8_SA(1, 0), cA + kstep, voffA); PG8_STAGE(PG8_SB(1, 1), cB + hstep + kstep, voffB);
        PG8_WAIT_V(6); PG8_BAR;
    }
    for (;;) {
        const bool has_next = S.next(ui + 1, nxt);
        const char* nA = has_next ? (const char*)g.A + (size_t)nxt.pm * tstep : cA; const char* nB = has_next ? (const char*)g.Bt + (size_t)nxt.pn * tstep : cB;
        for (int t = 0; t < nt; t += 2) {
            const bool last = (t == nt - 2);
            const char* a1 = cA + (size_t)(t + 1) * kstep;
            const char* a2 = last ? nA : cA + (size_t)(t + 2) * kstep; const char* b2 = last ? nB : cB + (size_t)(t + 2) * kstep;
            const char* a3 = a2 + kstep; const char* b3 = b2 + kstep;
            if (last && has_next) S.a_ready(nxt);
            if constexpr (SP2) {
            PG8_LDB(B0, 0, 0); PG8_LDB(B1, 0, 1); PG8_SCHED; PG8_LDA(At, 0, 0); PG8_STAGE(PG8_SA(1, 1), a1 + hstep, voffA);
            PG8_WAIT_V(8); PG8_WAIT_L(0); PG8_BAR; PG8_MMA(0, 0, At, B0); PG8_MMA(0, 1, At, B1); PG8_BAR; PG8_SCHED;
            PG8_LDA(At, 0, 1); PG8_STAGE(PG8_SB(0, 0), b2, voffB); PG8_STAGE(PG8_SB(0, 1), b2 + hstep, voffB); PG8_STAGE(PG8_SA(0, 0), a2, voffA);
            PG8_WAIT_V(8); PG8_WAIT_L(0); PG8_BAR; PG8_MMA(1, 0, At, B0); PG8_MMA(1, 1, At, B1); PG8_BAR; PG8_SCHED;
            PG8_LDB(B0, 1, 0); PG8_LDB(B1, 1, 1); PG8_SCHED; PG8_LDA(At, 1, 0); PG8_STAGE(PG8_SA(0, 1), a2 + hstep, voffA);
            PG8_WAIT_V(8); PG8_WAIT_L(0); PG8_BAR; PG8_MMA(0, 0, At, B0); PG8_MMA(0, 1, At, B1); PG8_BAR; PG8_SCHED;
            PG8_LDA(At, 1, 1); PG8_STAGE(PG8_SB(1, 0), b3, voffB); PG8_STAGE(PG8_SB(1, 1), b3 + hstep, voffB); PG8_STAGE(PG8_SA(1, 0), a3, voffA);
            PG8_WAIT_V(8); PG8_WAIT_L(0); PG8_BAR; PG8_MMA(1, 0, At, B0); PG8_MMA(1, 1, At, B1); PG8_BAR; PG8_SCHED;
            } else {
            PG8_LDB(B0, 0, 0); PG8_SCHED; PG8_LDA(At, 0, 0); PG8_STAGE(PG8_SA(1, 1), a1 + hstep, voffA);
            PG8_WAIT_L(8); PG8_BAR; PG8_WAIT_L(0); PG8_MMA(0, 0, At, B0); PG8_BAR; PG8_SCHED;
            PG8_LDB(B1, 0, 1); PG8_STAGE(PG8_SB(0, 0), b2, voffB);
            PG8_BAR; PG8_WAIT_L(0); PG8_MMA(0, 1, At, B1); PG8_BAR;
            PG8_LDA(At, 0, 1); PG8_STAGE(PG8_SA(0, 0), a2, voffA);
            PG8_BAR; PG8_WAIT_L(0); PG8_MMA(1, 0, At, B0); PG8_BAR; PG8_SCHED;
            PG8_STAGE(PG8_SB(0, 1), b2 + hstep, voffB);
            PG8_WAIT_V(6); PG8_BAR; PG8_MMA(1, 1, At, B1); PG8_BAR;
            PG8_LDB(B0, 1, 0); PG8_SCHED; PG8_LDA(At, 1, 0); PG8_STAGE(PG8_SA(0, 1), a2 + hstep, voffA);
            PG8_WAIT_L(8); PG8_BAR; PG8_WAIT_L(0); PG8_MMA(0, 0, At, B0); PG8_BAR; PG8_SCHED;
            PG8_LDB(B1, 1, 1); PG8_STAGE(PG8_SB(1, 0), b3, voffB);
            PG8_BAR; PG8_WAIT_L(0); PG8_MMA(0, 1, At, B1); PG8_BAR;
            PG8_LDA(At, 1, 1); PG8_STAGE(PG8_SA(1, 0), a3, voffA);
            PG8_BAR; PG8_WAIT_L(0); PG8_MMA(1, 0, At, B0); PG8_BAR; PG8_SCHED;
            PG8_STAGE(PG8_SB(1, 1), b3 + hstep, voffB);
            PG8_WAIT_V(6); PG8_BAR; PG8_MMA(1, 1, At, B1); PG8_BAR;
            }
        }
        if constexpr (ALIGN_EPI) { if (wr == 0) PG8_BAR; }
        if constexpr (!Epi::AFTER_DRAIN) { E(acc, cur, wr, wc, fr, fq, lds + STAGE_BYTES + wid * EPI_WAVE_BYTES); S.done(cur); }
        if (!has_next) break;
#pragma unroll
        for (int a = 0; a < 2; ++a)
#pragma unroll
            for (int b = 0; b < 2; ++b)
#pragma unroll
                for (int m = 0; m < 4; ++m)
#pragma unroll
                    for (int n = 0; n < 2; ++n) acc[a][b][m][n] = (f32x4){0.f, 0.f, 0.f, 0.f};
        cur = nxt; cA = nA; cB = nB; ++ui;
        if constexpr (ALIGN_EPI) { if (wr == 1) PG8_BAR; }
    }
    PG8_WAIT_V(0);
    if constexpr (!ALIGN_EPI) { if (wr == 0) PG8_BAR; }
    PG8_BAR;
#undef PG8_SA
#undef PG8_SB
#undef PG8_STAGE
#undef PG8_LDA
#undef PG8_LDB
#undef PG8_MMA
#undef PG8_WAIT_V
#undef PG8_WAIT_L
#undef PG8_BAR
#undef PG8_SCHED
}
}

#define XB_TMO      128
#define XB_XCNT(j)  (256  + 64 * (j))
#define XB_XSUB(j)  (1280 + 64 * (j))
#define XB_XGEN(j)  (2304 + 64 * (j))
#define XB_TOP      3328
#define XB_TOPGEN   3392
#define XCD_BAR_WORDS 3456
#define XB_SPIN_CAP (1u << 18)

__device__ __forceinline__ unsigned xb_ld(unsigned* p)              { return __hip_atomic_load(p, __ATOMIC_RELAXED, __HIP_MEMORY_SCOPE_AGENT); }
__device__ __forceinline__ unsigned xb_add(unsigned* p, unsigned v) { return __hip_atomic_fetch_add(p, v, __ATOMIC_RELAXED, __HIP_MEMORY_SCOPE_AGENT); }
__device__ __forceinline__ unsigned xb_xcc_id() { return (unsigned)__builtin_amdgcn_s_getreg((3 << 11) | 20) & 0xFu; }
#define XB_SPIN(cond, bar) do { unsigned _sp = 0; while (cond) { __builtin_amdgcn_s_sleep(1); \
    if ((++_sp & 255u) == 0u) { if (xb_ld(&(bar)[XB_TMO])) break; if (_sp > XB_SPIN_CAP) { atomicAdd(&(bar)[XB_TMO], 1u); break; } } } } while (0)

struct XcdBarrier {
    unsigned* bar; unsigned x;
    volatile LAS unsigned* st;
};

__device__ __forceinline__ XcdBarrier xcd_barrier_post(unsigned* bar, volatile LAS unsigned* st) {
    XcdBarrier b; b.bar = bar; b.x = xb_xcc_id(); b.st = st;
    if (threadIdx.x == 0) (void)xb_add(&bar[XB_XCNT(b.x)], 1u);
    return b;
}
__device__ __forceinline__ void xcd_barrier_complete(unsigned* bar, unsigned x, unsigned& nloc, unsigned& nx) {
    const unsigned G = gridDim.x * gridDim.y * gridDim.z;
    unsigned sum, cnt, mine, sp = 0u;
    for (;;) {
        sum = 0u; cnt = 0u; mine = 0u;
#pragma unroll
        for (unsigned j = 0; j < 16; ++j) { const unsigned c = xb_ld(&bar[XB_XCNT(j)]); sum += c; cnt += (c > 0u) ? 1u : 0u; mine = (j == x) ? c : mine; }
        if (sum == G) break;
        __builtin_amdgcn_s_sleep(1);
        if ((++sp & 255u) == 0u) { if (xb_ld(&bar[XB_TMO])) break; if (sp > XB_SPIN_CAP) { atomicAdd(&bar[XB_TMO], 1u); break; } }
    }
    nloc = mine > 0u ? mine : 1u; nx = cnt > 0u ? cnt : 1u;
}

__device__ __forceinline__ void xcd_barrier(const XcdBarrier& b) {
    asm volatile("s_waitcnt vmcnt(0)" ::: "memory");
    __syncthreads();
    if (threadIdx.x == 0) {
        unsigned* bar = b.bar;
        __builtin_amdgcn_s_waitcnt(0);
        unsigned nloc = b.st[0], nx = b.st[1];
        if (nloc == 0u) { xcd_barrier_complete(bar, b.x, nloc, nx); b.st[0] = nloc; b.st[1] = nx; }
        const unsigned old = xb_add(&bar[XB_XSUB(b.x)], 1u);
        const unsigned gen = old / nloc;
        if (old + 1u == (gen + 1u) * nloc) {
            __builtin_amdgcn_fence(__ATOMIC_RELEASE, "agent");
            asm volatile("s_waitcnt vmcnt(0)" ::: "memory");
            const unsigned og = xb_add(&bar[XB_TOP], 1u);
            const unsigned tg = og / nx;
            if (og + 1u == (tg + 1u) * nx) xb_add(&bar[XB_TOPGEN], 1u);
            else XB_SPIN(xb_ld(&bar[XB_TOPGEN]) == tg, bar);
            __builtin_amdgcn_fence(__ATOMIC_ACQUIRE, "agent");
            xb_add(&bar[XB_XGEN(b.x)], 1u);
            asm volatile("s_waitcnt vmcnt(0)" ::: "memory");
        } else {
            XB_SPIN(xb_ld(&bar[XB_XGEN(b.x)]) == gen, bar);
            __builtin_amdgcn_fence(__ATOMIC_ACQUIRE, "agent");
            asm volatile("s_waitcnt vmcnt(0)" ::: "memory");
        }
    }
    __syncthreads();
}

constexpr int NWAVES = 8, NTHREADS = NWAVES * 64;
constexpr int RING_BYTES = 131072, BARST_OFF = RING_BYTES + 8 * pg8::EPI_WAVE_BYTES, LDS_BYTES = BARST_OFF + 64;

__device__ __forceinline__ void transpose_item(const float* W, int N, bf16_t* WT, int ldt, int k0, int n0, int drow0, LAS float* scr, int lane, float scale = 1.0f, const float* gk = nullptr) {
    float wv[32];
#pragma unroll
    for (int i = 0; i < 32; ++i) { const int kk = 2 * i + (lane >> 5); wv[i] = W[(size_t)(k0 + kk) * N + n0 + (lane & 31)]; }
    if (gk) {
#pragma unroll
        for (int i = 0; i < 32; ++i) wv[i] *= gk[k0 + 2 * i + (lane >> 5)];
    }
#pragma unroll
    for (int i = 0; i < 32; ++i) { const int kk = 2 * i + (lane >> 5); scr[kk * 33 + (lane & 31)] = wv[i]; }
    asm volatile("s_waitcnt lgkmcnt(0)" ::: "memory");
    const int c = lane & 7;
#pragma unroll
    for (int j = 0; j < 4; ++j) { const int n = (lane >> 3) + 8 * j; const LAS float* s = scr + (8 * c) * 33 + n;
        u32x4 o; o.x = pk_bf16(s[0 * 33] * scale, s[1 * 33] * scale); o.y = pk_bf16(s[2 * 33] * scale, s[3 * 33] * scale); o.z = pk_bf16(s[4 * 33] * scale, s[5 * 33] * scale); o.w = pk_bf16(s[6 * 33] * scale, s[7 * 33] * scale);
        *(u32x4*)(WT + (size_t)(drow0 + n) * ldt + k0 + 8 * c) = o; }
    asm volatile("s_waitcnt lgkmcnt(0)" ::: "memory");
}

struct Args { const float* in[17]; float* out; unsigned char* ws; int ph_lo, ph_hi; };

__device__ __forceinline__ void p0_weights(const Args& a, LAS unsigned char* lds, int gw, int NGW, int wave, int lane, int gtid, int NGT) {
    LAS float* scr = (LAS float*)(lds + wave * 16384);
    unsigned char* ws = a.ws;
    constexpr int I_G = (DM / 64) * (DFF / 32);
    constexpr int I_D = (DFF / 64) * (DM / 32);
    constexpr int I_IN = (DM / 64) * (DIN / 32);
    constexpr int I_OUT = (DM / 64) * (DM / 32);
    constexpr int NITEMS = 2 * (2 * I_G + I_D) + I_IN + I_OUT;
    for (int it = gw; it < NITEMS; it += NGW) {
        int r = it;
        bool done = false;
#pragma unroll
        for (int f = 0; f < 2; ++f) {
            if (done) break;
            const float* Wg = a.in[f ? 13 : 2]; const float* Wu = a.in[f ? 14 : 3]; const float* Wd = a.in[f ? 15 : 4];
            bf16_t* WGU = (bf16_t*)(ws + (f ? WS_WGU2 : WS_WGU1)); bf16_t* WD = (bf16_t*)(ws + (f ? WS_WD2 : WS_WD1));
            if (r < 2 * I_G) { const int up = r >= I_G; const int q = up ? r - I_G : r; const int nblk = DFF / 32, kb = q / nblk, nb = q % nblk, n0 = nb * 32;
                transpose_item(up ? Wu : Wg, DFF, WGU, DM, kb * 64, n0, 256 * (n0 >> 7) + (n0 & 127) + (up ? 128 : 0), scr, lane, 1.0f, a.in[f ? 12 : 1]); done = true; break; }
            r -= 2 * I_G;
            if (r < I_D) { const int nblk = DM / 32, kb = r / nblk, nb = r % nblk; transpose_item(Wd, DM, WD, DFFP, kb * 64, nb * 32, nb * 32, scr, lane); done = true; break; }
            r -= I_D;
        }
        if (done) continue;
        if (r < I_IN) { const int nblk = DIN / 32, kb = r / nblk, nb = r % nblk; transpose_item(a.in[7], DIN, (bf16_t*)(ws + WS_WIN), DM, kb * 64, nb * 32, nb * 32, scr, lane, (nb * 32 >= QOFF && nb * 32 < KOFF_Z) ? QSCALE : 1.0f, a.in[6]); continue; }
        r -= I_IN;
        { const int nblk = DM / 32, kb = r / nblk, nb = r % nblk; transpose_item(a.in[10], DM, (bf16_t*)(ws + WS_WOUT), DM, kb * 64, nb * 32, nb * 32, scr, lane); }
    }
    for (int f = 0; f < 2; ++f) {
        u32x4* WGU = (u32x4*)(ws + (f ? WS_WGU2 : WS_WGU1)); u32x4* WD = (u32x4*)(ws + (f ? WS_WD2 : WS_WD1));
        for (int i = gtid; i < 128 * 128; i += NGT) { const int pr = i >> 7, c = i & 127; const int row = 256 * 21 + (pr < 64 ? 64 + pr : 128 + pr); WGU[(size_t)row * (DM / 8) + c] = (u32x4){0u, 0u, 0u, 0u}; }
        for (int i = gtid; i < 1024 * 8; i += NGT) { const int row = i >> 3, c = i & 7; WD[(size_t)row * (DFFP / 8) + (DFF / 8) + c] = (u32x4){0u, 0u, 0u, 0u}; }
    }
    { bf16_t* wlt = (bf16_t*)(ws + WS_WLT); const float* wl = a.in[8];
      for (int i = gtid; i < 4 * 64 * 64; i += NGT) { const int g = i >> 12, e = (i >> 6) & 63, c = i & 63; wlt[i] = (bf16_t)(pk_bf16(wl[g * 4096 + c * 64 + e], 0.f) & 0xffffu); } }
}

template <bool XIN_N, bool HAS_Y, bool OUT_F32>
__device__ __forceinline__ void norm_pass(const float* xin, bf16_t* hn, float* rinv, const bf16_t* y, const float* gpost, float coef, float* xout, int gw, int NGW, int lane) {
    f32x4 gp[4];
#pragma unroll
    for (int j = 0; j < 4; ++j) gp[j] = HAS_Y ? *(const f32x4*)(gpost + 4 * lane + 256 * j) : (f32x4){0.f, 0.f, 0.f, 0.f};
    f32x4 nv[4]; u32x2 nxr[4]; u32x2 nyr[4]; float nri = 0.f;
#define NP_LOAD(r_) do { \
        if constexpr (XIN_N) { const u32x2* xr = (const u32x2*)(hn + (size_t)(r_) * DM) + lane; _Pragma("unroll") for (int j = 0; j < 4; ++j) nxr[j] = xr[64 * j]; nri = rinv[r_]; } \
        else { const f32x4* xr = (const f32x4*)(xin + (size_t)(r_) * DM) + lane; _Pragma("unroll") for (int j = 0; j < 4; ++j) nv[j] = xr[64 * j]; } \
        if constexpr (HAS_Y) { const u32x2* yr = (const u32x2*)(y + (size_t)(r_) * DM) + lane; _Pragma("unroll") for (int j = 0; j < 4; ++j) nyr[j] = yr[64 * j]; } } while (0)
    if (gw < MROWS) NP_LOAD(gw);
    for (int row = gw; row < MROWS; row += NGW) {
        f32x4 v[4]; u32x2 yraw[4];
#pragma unroll
        for (int j = 0; j < 4; ++j) {
            if constexpr (XIN_N) v[j] = (f32x4){bf_lo(nxr[j].x), bf_hi(nxr[j].x), bf_lo(nxr[j].y), bf_hi(nxr[j].y)} * nri; else v[j] = nv[j];
            if constexpr (HAS_Y) yraw[j] = nyr[j]; }
        const int nrow = row + NGW;
        if (nrow < MROWS) NP_LOAD(nrow);
        if constexpr (HAS_Y) {
            f32x4 yv[4]; float ss = 0.f;
#pragma unroll
            for (int j = 0; j < 4; ++j) { const u32x2 u = yraw[j]; yv[j] = (f32x4){bf_lo(u.x), bf_hi(u.x), bf_lo(u.y), bf_hi(u.y)}; ss += (yv[j].x * yv[j].x + yv[j].y * yv[j].y) + (yv[j].z * yv[j].z + yv[j].w * yv[j].w); }
            const float r = coef * __builtin_amdgcn_rsqf(wave_sum(ss) * (1.0f / DM) + RMS_EPS);
#pragma unroll
            for (int j = 0; j < 4; ++j) v[j] = v[j] + yv[j] * gp[j] * r;
        }
        if constexpr (OUT_F32) {
            f32x4* xo = (f32x4*)(xout + (size_t)row * DM) + lane;
#pragma unroll
            for (int j = 0; j < 4; ++j) xo[64 * j] = v[j];
        } else {
            float ss = 0.f;
#pragma unroll
            for (int j = 0; j < 4; ++j) ss += (v[j].x * v[j].x + v[j].y * v[j].y) + (v[j].z * v[j].z + v[j].w * v[j].w);
            const float ms = wave_sum(ss) * (1.0f / DM) + RMS_EPS;
            const float r = __builtin_amdgcn_rsqf(ms);
            u32x2* ho = (u32x2*)(hn + (size_t)row * DM) + lane;
#pragma unroll
            for (int j = 0; j < 4; ++j) { const f32x4 h = v[j] * r; ho[64 * j] = (u32x2){pk_bf16(h.x, h.y), pk_bf16(h.z, h.w)}; }
            if (lane == 0) rinv[row] = __builtin_sqrtf(ms);
        }
    }
#undef NP_LOAD
}

template <int GI>
__device__ __forceinline__ void pool_task(const bf16_t* z, const bf16_t* wlt, const float* pscale, bf16_t* mix, int strip, int lane) {
    constexpr int HW = 1 << GI, WN = 2 * HW;
    const int fr = lane & 15, fq = lane >> 4;
    const int row = strip * 16 + fr, t = row & (SEQ - 1), bbase = row - t;
    const int lo = max(t - HW, 0), hi = min(t + HW, SEQ);
    const float inv = 1.0f / (float)(hi - lo);
    bf16x8 yb[2];
#pragma unroll
    for (int kk = 0; kk < 2; ++kk) {
        const int c0 = GI * 64 + 8 * fq + 32 * kk;
        u32x4 ld[WN];
#pragma unroll
        for (int i = 0; i < WN; ++i) { const int tt = min(max(t - HW + i, 0), SEQ - 1); ld[i] = *(const u32x4*)(z + (size_t)(bbase + tt) * DIN + c0); }
        float s[8];
#pragma unroll
        for (int e = 0; e < 8; ++e) s[e] = 0.f;
#pragma unroll
        for (int i = 0; i < WN; ++i) { const int tt = t - HW + i; const float mk = (tt >= 0 && tt < SEQ) ? 1.0f : 0.0f; const u32x4 u = ld[i];
            s[0] += mk * bf_lo(u.x); s[1] += mk * bf_hi(u.x); s[2] += mk * bf_lo(u.y); s[3] += mk * bf_hi(u.y); s[4] += mk * bf_lo(u.z); s[5] += mk * bf_hi(u.z); s[6] += mk * bf_lo(u.w); s[7] += mk * bf_hi(u.w); }
        const u32x4 u = ld[HW];
        u32x4 p; p.x = pk_bf16(s[0] * inv - bf_lo(u.x), s[1] * inv - bf_hi(u.x)); p.y = pk_bf16(s[2] * inv - bf_lo(u.y), s[3] * inv - bf_hi(u.y));
        p.z = pk_bf16(s[4] * inv - bf_lo(u.z), s[5] * inv - bf_hi(u.z)); p.w = pk_bf16(s[6] * inv - bf_lo(u.w), s[7] * inv - bf_hi(u.w));
        yb[kk] = __builtin_bit_cast(bf16x8, p);
    }
#pragma unroll
    for (int eb = 0; eb < 4; ++eb) {
        f32x4 acc = {0.f, 0.f, 0.f, 0.f};
#pragma unroll
        for (int kk = 0; kk < 2; ++kk) { const bf16x8 wa = *(const bf16x8*)(wlt + (size_t)GI * 4096 + (16 * eb + fr) * 64 + 8 * fq + 32 * kk);
            acc = __builtin_amdgcn_mfma_f32_16x16x32_bf16(wa, yb[kk], acc, 0, 0, 0); }
        const f32x4 sc = *(const f32x4*)(pscale + GI * 64 + 16 * eb + 4 * fq);
        acc = acc * sc;
        *(u32x2*)(mix + (size_t)row * DM + GI * 64 + 16 * eb + 4 * fq) = (u32x2){pk_bf16(acc.x, acc.y), pk_bf16(acc.z, acc.w)};
    }
}
__device__ __forceinline__ void pool_phase(const bf16_t* z, const bf16_t* wlt, const float* pscale, bf16_t* mix, int gw, int NGW, int lane) {
    for (int strip = gw; strip < MROWS / 16; strip += NGW) {
        pool_task<0>(z, wlt, pscale, mix, strip, lane); pool_task<1>(z, wlt, pscale, mix, strip, lane);
        pool_task<2>(z, wlt, pscale, mix, strip, lane); pool_task<3>(z, wlt, pscale, mix, strip, lane);
    }
}

constexpr int AT_PITCH = 144, AT_ROWS = 272, AT_KOFF = 0, AT_VOFF = AT_ROWS * AT_PITCH;
struct AtUnit { int h, dsh, L, n0; size_t rowbase; };
__device__ __forceinline__ AtUnit at_decode(int unit) {
    AtUnit u; const int bh = unit >> 6, j = unit & 63, b = bh / NHEAD; u.h = bh - b * NHEAD; const int g = u.h >> 2;
    u.dsh = 2 * g; u.L = SEQ >> u.dsh;
    const int r = j >> (6 - u.dsh), c = j & ((64 >> u.dsh) - 1); u.n0 = c * 128; u.rowbase = (size_t)b * SEQ + r; return u;
}
__device__ __forceinline__ void at_fetch(const bf16_t* z, const AtUnit& u, int tid, int w, int fr, int fq, u32x4 (&kv)[4], u32x4 (&vv)[4], bf16x8 (&qf)[2]) {
#pragma unroll
    for (int i = 0; i < 4; ++i) { const int id = tid + NTHREADS * i, row = id >> 3, ch = id & 7, n = u.n0 - 64 + row;
        kv[i] = (u32x4){0u, 0u, 0u, 0u}; vv[i] = kv[i];
        if (n >= 0 && n < u.L) { const bf16_t* src = z + (u.rowbase + ((size_t)n << u.dsh)) * DIN + u.h * 64 + ch * 8; kv[i] = *(const u32x4*)(src + KOFF_Z); vv[i] = *(const u32x4*)(src + VOFF_Z); } }
    const size_t qrow = u.rowbase + ((size_t)(u.n0 + 16 * w + fr) << u.dsh);
#pragma unroll
    for (int kk = 0; kk < 2; ++kk) qf[kk] = *(const bf16x8*)(z + qrow * DIN + QOFF + u.h * 64 + 8 * fq + 32 * kk);
}
__device__ __forceinline__ void attn_phase(LAS unsigned char* lds, const bf16_t* z, bf16_t* mix, float* lse, int G, int bid, int tid) {
    const int lane = tid & 63, w = __builtin_amdgcn_readfirstlane(tid >> 6), fr = lane & 15, fq = lane >> 4;
    constexpr int NUNITS = BATCH * NHEAD * 64;
    for (int i = tid; i < 16 * AT_PITCH / 4; i += NTHREADS) { ((LAS unsigned*)(lds + AT_VOFF + 256 * AT_PITCH))[i] = 0u; ((LAS unsigned*)(lds + AT_KOFF + 256 * AT_PITCH))[i] = 0u; }
    float abst[9][4];
#pragma unroll
    for (int kt = 0; kt < 9; ++kt)
#pragma unroll
        for (int e = 0; e < 4; ++e) { const int rel = 16 * kt + 4 * fq + e - 64 - fr; abst[kt][e] = (rel < -64 || rel > 64) ? INFINITY : (float)(rel < 0 ? -rel : rel); }
    u32x4 kv[4], vv[4]; bf16x8 qn[2];
    if (bid < NUNITS) { const AtUnit u0 = at_decode(bid); at_fetch(z, u0, tid, w, fr, fq, kv, vv, qn); }
    for (int unit = bid; unit < NUNITS; unit += G) {
        const AtUnit u = at_decode(unit);
        const int h = u.h, dsh = u.dsh, L = u.L, n0 = u.n0;
        __syncthreads();
#pragma unroll
        for (int i = 0; i < 4; ++i) { const int id = tid + NTHREADS * i, row = id >> 3, ch = id & 7;
            *(LAS u32x4*)(lds + AT_KOFF + row * AT_PITCH + ch * 16) = kv[i]; *(LAS u32x4*)(lds + AT_VOFF + row * AT_PITCH + ch * 16) = vv[i]; }
        bf16x8 qf[2]; qf[0] = qn[0]; qf[1] = qn[1];
        const size_t qrow = u.rowbase + ((size_t)(n0 + 16 * w + fr) << dsh);
        __syncthreads();
        if (unit + G < NUNITS) { const AtUnit un = at_decode(unit + G); at_fetch(z, un, tid, w, fr, fq, kv, vv, qn); }
        f32x4 s[9];
#pragma unroll
        for (int kt = 0; kt < 9; ++kt) {
            const LAS unsigned char* kp = lds + AT_KOFF + (16 * w + 16 * kt + fr) * AT_PITCH + 16 * fq;
            const bf16x8 a0 = *(const LAS bf16x8*)kp, a1 = *(const LAS bf16x8*)(kp + 64);
            f32x4 acc = {0.f, 0.f, 0.f, 0.f};
            acc = __builtin_amdgcn_mfma_f32_16x16x32_bf16(a0, qf[0], acc, 0, 0, 0);
            acc = __builtin_amdgcn_mfma_f32_16x16x32_bf16(a1, qf[1], acc, 0, 0, 0);
            s[kt] = acc;
        }
        const float negc2 = -exp2f(-8.0f * (float)(h + 1) / 12.0f) * (float)(1 << dsh) * 1.44269504089f;
#pragma unroll
        for (int kt = 0; kt < 9; ++kt)
#pragma unroll
            for (int e = 0; e < 4; ++e) s[kt][e] = __builtin_fmaf(abst[kt][e], negc2, s[kt][e]);
        const int kb = n0 - 64 + 16 * w;
        if (kb < 0 || kb + 144 > L) {
#pragma unroll
            for (int kt = 0; kt < 9; ++kt)
#pragma unroll
                for (int e = 0; e < 4; ++e) { const int nk = kb + 16 * kt + 4 * fq + e; s[kt][e] = ((unsigned)nk < (unsigned)L) ? s[kt][e] : -INFINITY; }
        }
        float mx = s[0][0];
#pragma unroll
        for (int kt = 0; kt < 9; ++kt)
#pragma unroll
            for (int e = 0; e < 4; ++e) mx = fmaxf(mx, s[kt][e]);
        mx = fmaxf(mx, __shfl_xor(mx, 16)); mx = fmaxf(mx, __shfl_xor(mx, 32));
        float sum = 0.f;
#pragma unroll
        for (int kt = 0; kt < 9; ++kt)
#pragma unroll
            for (int e = 0; e < 4; ++e) { const float p = __builtin_amdgcn_exp2f(s[kt][e] - mx); s[kt][e] = p; sum += p; }
        sum += __shfl_xor(sum, 16); sum += __shfl_xor(sum, 32);
        f32x4 o[4];
#pragma unroll
        for (int db = 0; db < 4; ++db) o[db] = (f32x4){0.f, 0.f, 0.f, 0.f};
        const int tq = (lane & 15) >> 2, tp = lane & 3;
#pragma unroll
        for (int cc = 0; cc < 5; ++cc) {
            u32x4 pp; pp.x = pk_bf16(s[2 * cc][0], s[2 * cc][1]); pp.y = pk_bf16(s[2 * cc][2], s[2 * cc][3]);
            if (cc < 4) { pp.z = pk_bf16(s[2 * cc + 1][0], s[2 * cc + 1][1]); pp.w = pk_bf16(s[2 * cc + 1][2], s[2 * cc + 1][3]); } else { pp.z = 0u; pp.w = 0u; }
            const bf16x8 pb = __builtin_bit_cast(bf16x8, pp);
            const LAS unsigned char* vp = lds + AT_VOFF + (16 * w + 32 * cc + 4 * fq + tq) * AT_PITCH + 8 * tp;
#pragma unroll
            for (int db = 0; db < 4; ++db) {
                const s16x4 v0 = __builtin_amdgcn_ds_read_tr16_b64_v4i16((LAS s16x4*)(vp + 32 * db));
                const s16x4 v1 = __builtin_amdgcn_ds_read_tr16_b64_v4i16((LAS s16x4*)(vp + 16 * AT_PITCH + 32 * db));
                const bf16x8 va = {v0[0], v0[1], v0[2], v0[3], v1[0], v1[1], v1[2], v1[3]};
                o[db] = __builtin_amdgcn_mfma_f32_16x16x32_bf16(va, pb, o[db], 0, 0, 0);
            }
        }
        const float inv = 1.0f / sum;
        bf16_t* op = mix + qrow * DM + 256 + h * 64 + 4 * fq;
#pragma unroll
        for (int db = 0; db < 4; ++db) { const f32x4 v = o[db] * inv; *(u32x2*)(op + 16 * db) = (u32x2){pk_bf16(v.x, v.y), pk_bf16(v.z, v.w)}; }
        if (fq == 0) lse[qrow * NHEAD + h] = (mx + __builtin_amdgcn_logf(sum)) * 0.69314718056f;
    }
    __syncthreads();
}

__device__ __forceinline__ void alpha_pass(bf16_t* mix, const float* lse, int gw, int NGW, int lane) {
    const int hg = lane >> 4;
    for (int row = gw; row < MROWS; row += NGW) {
        const float* lr = lse + (size_t)row * NHEAD;
        const float l0 = lr[hg], l1 = lr[4 + hg], l2 = lr[8 + hg];
        const float m = fmaxf(l0, fmaxf(l1, l2));
        const float e0 = __expf(l0 - m), e1 = __expf(l1 - m), e2 = __expf(l2 - m);
        const float inv = 1.0f / (e0 + e1 + e2);
        const float al[3] = {e0 * inv, e1 * inv, e2 * inv};
        u32x2* p = (u32x2*)(mix + (size_t)row * DM + 256) + lane;
#pragma unroll
        for (int i = 0; i < 3; ++i) { const u32x2 u = p[64 * i]; const float a = al[i];
            p[64 * i] = (u32x2){pk_bf16(bf_lo(u.x) * a, bf_hi(u.x) * a), pk_bf16(bf_lo(u.y) * a, bf_hi(u.y) * a)}; }
    }
}

__global__ void __launch_bounds__(NTHREADS, 2) fwd_kernel(Args args) {
    extern __shared__ __attribute__((aligned(16))) unsigned char lds_raw[];
    LAS unsigned char* lds = (LAS unsigned char*)lds_raw;
    cg::grid_group grid = cg::this_grid();
    const int tid = threadIdx.x, lane = tid & 63, wave = __builtin_amdgcn_readfirstlane(tid >> 6);
    const int G = gridDim.x, bid = blockIdx.x;
    const int gw = bid * NWAVES + wave, NGW = G * NWAVES, gtid = bid * NTHREADS + tid, NGT = G * NTHREADS;
    unsigned char* ws = args.ws;
    bf16_t* WGU1 = (bf16_t*)(ws + WS_WGU1); bf16_t* WD1 = (bf16_t*)(ws + WS_WD1); bf16_t* WIN = (bf16_t*)(ws + WS_WIN); bf16_t* WOUT = (bf16_t*)(ws + WS_WOUT);
    bf16_t* WGU2 = (bf16_t*)(ws + WS_WGU2); bf16_t* WD2 = (bf16_t*)(ws + WS_WD2); bf16_t* WLT = (bf16_t*)(ws + WS_WLT);
    float* LSE = (float*)(ws + WS_LSE); float* RINV = (float*)(ws + WS_RINV);
    bf16_t* HB = (bf16_t*)(ws + WS_H); bf16_t* YB = (bf16_t*)(ws + WS_Y); bf16_t* AB = (bf16_t*)(ws + WS_A); bf16_t* ZB = AB; bf16_t* XB = (bf16_t*)(ws + WS_XB);
    const float* x = args.in[0]; float* out = args.out;
    const int lo = args.ph_lo, hi = args.ph_hi;
    if (tid < 16) ((LAS unsigned*)(lds + BARST_OFF))[tid] = 0u;
    __syncthreads();
    XcdBarrier bar = xcd_barrier_post((unsigned*)(ws + WS_CTL), (volatile LAS unsigned*)(lds + BARST_OFF));
    if (lo < 0) grid.sync();
#define IN(k) (lo <= (k) && (k) < hi)
#define SEAM(k) do { if (IN(k) && IN((k) + 1)) xcd_barrier(bar); } while (0)

    if (IN(0)) { p0_weights(args, lds, gw, NGW, wave, lane, gtid, NGT);
        norm_pass<false, false, false>(x, HB, RINV, nullptr, nullptr, 0.f, nullptr, gw, NGW, lane); }
    SEAM(0);
    if (IN(1)) { pg8::Gemm g{HB, WGU1, MROWS, NGU, DM}; pg8::StaticOrder S; S.init(MROWS, NGU, G, bid); pg8::EpiSwiGLU E{AB, DFFP};
        pg8::gemm_phase<pg8::EpiSwiGLU, pg8::StaticOrder, true, true>(lds, g, S, E); }
    SEAM(1);
    if (IN(2)) { pg8::Gemm g{AB, WD1, MROWS, DM, DFFP}; pg8::StaticOrder S; S.init(MROWS, DM, G, bid); pg8::EpiBf16 E{YB, DM};
        pg8::gemm_phase<pg8::EpiBf16, pg8::StaticOrder, true, true>(lds, g, S, E); }
    SEAM(2);
    if (IN(3)) norm_pass<true, true, false>(nullptr, HB, RINV, YB, args.in[5], 0.5f, nullptr, gw, NGW, lane);
    SEAM(3);
    if (IN(4)) { pg8::Gemm g{HB, WIN, MROWS, DIN, DM}; pg8::StaticOrder S; S.init(MROWS, DIN, G, bid); pg8::EpiBf16 E{ZB, DIN};
        pg8::gemm_phase<pg8::EpiBf16, pg8::StaticOrder, true, true>(lds, g, S, E); }
    SEAM(4);
    if (IN(5)) { pool_phase(ZB, WLT, args.in[9], XB, gw, NGW, lane); attn_phase(lds, ZB, XB, LSE, G, bid, tid); }
    SEAM(5);
    if (IN(6)) alpha_pass(XB, LSE, gw, NGW, lane);
    SEAM(6);
    if (IN(7)) { pg8::Gemm g{XB, WOUT, MROWS, DM, DM}; pg8::StaticOrder S; S.init(MROWS, DM, G, bid); pg8::EpiBf16 E{YB, DM};
        pg8::gemm_phase<pg8::EpiBf16, pg8::StaticOrder, true, true>(lds, g, S, E); }
    SEAM(7);
    if (IN(8)) norm_pass<true, true, false>(nullptr, HB, RINV, YB, args.in[11], 1.0f, nullptr, gw, NGW, lane);
    SEAM(8);
    if (IN(9)) { pg8::Gemm g{HB, WGU2, MROWS, NGU, DM}; pg8::StaticOrder S; S.init(MROWS, NGU, G, bid); pg8::EpiSwiGLU E{AB, DFFP};
        pg8::gemm_phase<pg8::EpiSwiGLU, pg8::StaticOrder, true, true>(lds, g, S, E); }
    SEAM(9);
    if (IN(10)) { pg8::Gemm g{AB, WD2, MROWS, DM, DFFP}; pg8::StaticOrder S; S.init(MROWS, DM, G, bid); pg8::EpiBf16 E{YB, DM};
        pg8::gemm_phase<pg8::EpiBf16, pg8::StaticOrder, true, true>(lds, g, S, E); }
    SEAM(10);
    if (IN(11)) norm_pass<true, true, true>(nullptr, HB, RINV, YB, args.in[16], 0.5f, out, gw, NGW, lane);
#undef IN
#undef SEAM
}

constexpr int NPHASES = 12;
#ifndef MK_PER_PHASE
#define MK_PER_PHASE 0
#endif

extern "C" void kernel_launch(void* const* d_in, const int* in_sizes, int n_in, void* d_out, int out_size, void* d_ws, size_t ws_size, hipStream_t stream) {
    static int grid = 0;
    if (grid == 0) {
        if (n_in != 17 || out_size != MROWS * DM || ws_size < WS_END) { fprintf(stderr, "kernel_launch: unexpected shapes (n_in %d out %d ws %zu)\n", n_in, out_size, ws_size); grid = -1; return; }
        int dev = 0, cus = 0, per_cu = 0;
        hipGetDevice(&dev);
        hipDeviceGetAttribute(&cus, hipDeviceAttributeMultiprocessorCount, dev);
        if (hipFuncSetAttribute((const void*)fwd_kernel, hipFuncAttributeMaxDynamicSharedMemorySize, LDS_BYTES) != hipSuccess) { fprintf(stderr, "kernel_launch: hipFuncSetAttribute failed\n"); grid = -1; return; }
        if (hipOccupancyMaxActiveBlocksPerMultiprocessor(&per_cu, (const void*)fwd_kernel, NTHREADS, LDS_BYTES) != hipSuccess || per_cu < 1) { fprintf(stderr, "kernel_launch: occupancy query gave %d\n", per_cu); per_cu = 1; }
        (void)hipGetLastError();
        grid = cus * per_cu;
        fprintf(stderr, "kernel_launch: cus %d per_cu %d grid %d\n", cus, per_cu, grid);
    }
    if (grid < 0) return;
    Args a{};
    for (int i = 0; i < 17; ++i) a.in[i] = (const float*)d_in[i];
    a.out = (float*)d_out; a.ws = (unsigned char*)d_ws;
#if MK_PER_PHASE
    for (int p = 0; p < NPHASES; ++p) { a.ph_lo = p; a.ph_hi = p + 1; hipLaunchKernelGGL(fwd_kernel, dim3(grid), dim3(NTHREADS), LDS_BYTES, stream, a); }
#else
    a.ph_lo = 0; a.ph_hi = NPHASES;
    if (hipMemsetAsync((char*)d_ws + WS_CTL, 0, CTL_BYTES, stream) != hipSuccess) { fprintf(stderr, "kernel_launch: memset failed\n"); return; }
    void* kargs[] = {&a};
    hipError_t e = hipLaunchCooperativeKernel((const void*)fwd_kernel, dim3(grid), dim3(NTHREADS), kargs, LDS_BYTES, stream);
    if (e != hipSuccess) fprintf(stderr, "kernel_launch: cooperative launch failed: %s (grid %d)\n", hipGetErrorString(e), grid);
#endif
}
```
